# Optimizing an MI355X kernel written in HIP

```python
import jax, jax.numpy as jnp
from jax import lax
import numpy as np

D_MODEL = 1024
BATCH = 8
SEQ = 4096
DEPTH = 2

N_MIXERS = 2
N_RWKV_LAYERS = (DEPTH + 1) // 2
N_GMLP_LAYERS = DEPTH // 2
N_MEM = 256

RWKV_HEAD = 64
RWKV_HEADS = D_MODEL // RWKV_HEAD
LORA_DECAY = 64
LORA_AAA = 64
LORA_GATE = 160
GN_EPS = 64e-5

GMLP_CHUNK = 128
GMLP_WIDTH = 2 * D_MODEL
GMLP_GROUP_DIM = 128
GMLP_GROUPS = GMLP_WIDTH // GMLP_GROUP_DIM

XATTN_HEADS = 4
XATTN_HEAD_DIM = D_MODEL // XATTN_HEADS

D_FF = 2816
RMS_EPS = 1e-6

kernel_name = "rwkv7_gmlp_interleaved_macaron_memxattn"


def rms_norm(x, g):
    x32 = x.astype(jnp.float32)
    y = x32 * lax.rsqrt(jnp.mean(x32 * x32, axis=-1, keepdims=True) + RMS_EPS)
    return (y * g.astype(jnp.float32)).astype(x.dtype)


def swiglu_ffn(h, w_in, w_out):
    gate, up = jnp.split(h @ w_in, 2, axis=-1)
    return (jax.nn.silu(gate) * up) @ w_out


def token_shift(x):
    return jnp.pad(x[:, :-1], ((0, 0), (1, 0), (0, 0)))


def rwkv7_time_mix(h, mu, w_rkv, w0, w1, w2, a0, a1, a2, g1, g2, k_k, k_a, r_k, ln_w, ln_b, w_o):
    B, S, C = h.shape
    H, N = RWKV_HEADS, RWKV_HEAD
    dx = token_shift(h) - h
    xr = h + dx * mu[0]
    xw = h + dx * mu[1]
    xk = h + dx * mu[2]
    xv = h + dx * mu[3]
    xa = h + dx * mu[4]
    xg = h + dx * mu[5]
    x3 = jnp.stack([xr, xk, xv], axis=0)
    rkv = jnp.einsum('nbsc,cnd->nbsd', x3, w_rkv.reshape(C, 3, C))
    r, k, v = rkv[0], rkv[1], rkv[2]
    w = -jax.nn.softplus(-(w0 + jnp.tanh(xw @ w1) @ w2)) - 0.5
    decay = jnp.exp(-jnp.exp(w.astype(jnp.float32)))
    a = jax.nn.sigmoid(a0 + (xa @ a1) @ a2)
    g = jax.nn.sigmoid(xg @ g1) @ g2
    kk = (k * k_k).reshape(B, S, H, N).astype(jnp.float32)
    kk = kk / jnp.maximum(jnp.linalg.norm(kk, axis=-1, keepdims=True), 1e-12)
    k = k * (1.0 + (a - 1.0) * k_a)

    def heads(t):
        return t.reshape(B, S, H, N).astype(jnp.float32)

    r_h, k_h, v_h, a_h = heads(r), heads(k), heads(v), heads(a)
    b_h = kk * a_h
    xs = tuple(jnp.moveaxis(t, 1, 0) for t in (r_h, heads(decay), k_h, v_h, kk, b_h))

    def step(state, inp):
        r_t, w_t, k_t, v_t, kk_t, b_t = inp
        sa = jnp.einsum('bhij,bhj->bhi', state, -kk_t)
        state = (state * w_t[:, :, None, :] + sa[..., None] * b_t[:, :, None, :]
                 + v_t[..., :, None] * k_t[:, :, None, :])
        y = jnp.einsum('bhij,bhj->bhi', state, r_t)
        return state, y

    s0 = jnp.zeros((B, H, N, N), jnp.float32)
    _, ys = lax.scan(step, s0, xs)
    y = jnp.moveaxis(ys, 0, 1)
    mean = jnp.mean(y, axis=-1, keepdims=True)
    var = jnp.mean(jnp.square(y - mean), axis=-1, keepdims=True)
    y = ((y - mean) * lax.rsqrt(var + GN_EPS)).reshape(B, S, C)
    y = y * ln_w.astype(jnp.float32) + ln_b.astype(jnp.float32)
    bonus = jnp.sum(r_h * k_h * r_k.astype(jnp.float32), axis=-1, keepdims=True) * v_h
    y = (y + bonus.reshape(B, S, C)).astype(h.dtype)
    return (y * g) @ w_o


def gmlp_chunk_mix(h, w_uv, v_norm, w_s, b_s, w_o):
    B, S, _ = h.shape
    z = jax.nn.gelu(h @ w_uv)
    u, v = jnp.split(z, 2, axis=-1)
    v = rms_norm(v, v_norm)
    v = v.reshape(B, S // GMLP_CHUNK, GMLP_CHUNK, GMLP_GROUPS, GMLP_GROUP_DIM)
    causal = jnp.tril(jnp.ones((GMLP_CHUNK, GMLP_CHUNK), dtype=bool))
    ws = jnp.where(causal[None], w_s, jnp.zeros_like(w_s))
    sv = jnp.einsum('gts,bcsgd->bctgd', ws, v) + jnp.transpose(b_s)[:, :, None]
    sv = sv.reshape(B, S, GMLP_WIDTH)
    return (u * sv) @ w_o


def memory_cross_attention(h, mem_k, mem_v, wq, wo):
    B, S, C = h.shape
    q = (h @ wq).reshape(B, S, XATTN_HEADS, XATTN_HEAD_DIM)
    s = jnp.einsum('bshd,bmhd->bhsm', q, mem_k).astype(jnp.float32) * (XATTN_HEAD_DIM ** -0.5)
    p = jax.nn.softmax(s, axis=-1).astype(h.dtype)
    o = jnp.einsum('bhsm,bmhd->bshd', p, mem_v).reshape(B, S, C)
    return o @ wo


def setup_inputs(seed: int = 0) -> dict:
    key = jax.random.key(seed)
    ks = iter(jax.random.split(key, 48))
    C, F = D_MODEL, D_FF
    L, NA, NB = DEPTH, N_RWKV_LAYERS, N_GMLP_LAYERS

    def nrm(shape, scale):
        return jax.random.normal(next(ks), shape, jnp.float32) * scale

    def gain(shape):
        return 1.0 + 0.05 * jax.random.normal(next(ks), shape, jnp.float32)

    return {
        "x": jax.random.normal(next(ks), (BATCH, SEQ, C), jnp.float32),
        "mem": jax.random.normal(next(ks), (BATCH, N_MEM, C), jnp.float32),
        "mem_norm": gain((C,)),
        "mem_w_kv": nrm((C, 2 * C), C ** -0.5),
        "ffn1_norm": gain((L, C)),
        "ffn1_w_in": nrm((L, C, 2 * F), C ** -0.5),
        "ffn1_w_out": nrm((L, F, C), F ** -0.5),
        "mix_norm": gain((L, C)),
        "xattn_norm": gain((L, C)),
        "xattn_wq": nrm((L, C, C), C ** -0.5),
        "xattn_wo": nrm((L, C, C), C ** -0.5),
        "ffn2_norm": gain((L, C)),
        "ffn2_w_in": nrm((L, C, 2 * F), C ** -0.5),
        "ffn2_w_out": nrm((L, F, C), F ** -0.5),
        "rwkv_mu": jax.random.uniform(next(ks), (NA, 6, C), jnp.float32),
        "rwkv_w_rkv": nrm((NA, C, 3 * C), C ** -0.5),
        "rwkv_w0": jax.random.uniform(next(ks), (NA, C), jnp.float32, -6.0, -0.5),
        "rwkv_w1": nrm((NA, C, LORA_DECAY), C ** -0.5),
        "rwkv_w2": nrm((NA, LORA_DECAY, C), 0.5 * LORA_DECAY ** -0.5),
        "rwkv_a0": nrm((NA, C), 0.1),
        "rwkv_a1": nrm((NA, C, LORA_AAA), C ** -0.5),
        "rwkv_a2": nrm((NA, LORA_AAA, C), 0.5 * LORA_AAA ** -0.5),
        "rwkv_g1": nrm((NA, C, LORA_GATE), C ** -0.5),
        "rwkv_g2": nrm((NA, LORA_GATE, C), LORA_GATE ** -0.5),
        "rwkv_k_k": gain((NA, C)),
        "rwkv_k_a": gain((NA, C)),
        "rwkv_r_k": nrm((NA, RWKV_HEADS, RWKV_HEAD), 0.1),
        "rwkv_ln_w": gain((NA, C)),
        "rwkv_ln_b": nrm((NA, C), 0.01),
        "rwkv_w_o": nrm((NA, C, C), C ** -0.5),
        "gmlp_w_uv": nrm((NB, C, 2 * GMLP_WIDTH), C ** -0.5),
        "gmlp_v_norm": gain((NB, GMLP_WIDTH)),
        "gmlp_w_s": nrm((NB, GMLP_GROUPS, GMLP_CHUNK, GMLP_CHUNK), 0.5 * GMLP_CHUNK ** -0.5),
        "gmlp_b_s": gain((NB, GMLP_GROUPS, GMLP_CHUNK)),
        "gmlp_w_o": nrm((NB, GMLP_WIDTH, C), GMLP_WIDTH ** -0.5),
        "final_norm": gain((C,)),
    }


def reference(x, mem, mem_norm, mem_w_kv,
              ffn1_norm, ffn1_w_in, ffn1_w_out, mix_norm, xattn_norm, xattn_wq, xattn_wo,
              ffn2_norm, ffn2_w_in, ffn2_w_out,
              rwkv_mu, rwkv_w_rkv, rwkv_w0, rwkv_w1, rwkv_w2, rwkv_a0, rwkv_a1, rwkv_a2,
              rwkv_g1, rwkv_g2, rwkv_k_k, rwkv_k_a, rwkv_r_k, rwkv_ln_w, rwkv_ln_b, rwkv_w_o,
              gmlp_w_uv, gmlp_v_norm, gmlp_w_s, gmlp_b_s, gmlp_w_o,
              final_norm):
    B = mem.shape[0]
    mem_k, mem_v = jnp.split(rms_norm(mem, mem_norm) @ mem_w_kv, 2, axis=-1)
    mem_k = mem_k.reshape(B, N_MEM, XATTN_HEADS, XATTN_HEAD_DIM)
    mem_v = mem_v.reshape(B, N_MEM, XATTN_HEADS, XATTN_HEAD_DIM)

    for i in range(DEPTH):
        x = x + 0.5 * swiglu_ffn(rms_norm(x, ffn1_norm[i]), ffn1_w_in[i], ffn1_w_out[i])
        h = rms_norm(x, mix_norm[i])
        j = i // N_MIXERS
        if i % N_MIXERS == 0:
            y = rwkv7_time_mix(h, rwkv_mu[j], rwkv_w_rkv[j], rwkv_w0[j], rwkv_w1[j], rwkv_w2[j],
                               rwkv_a0[j], rwkv_a1[j], rwkv_a2[j], rwkv_g1[j], rwkv_g2[j],
                               rwkv_k_k[j], rwkv_k_a[j], rwkv_r_k[j], rwkv_ln_w[j], rwkv_ln_b[j],
                               rwkv_w_o[j])
        else:
            y = gmlp_chunk_mix(h, gmlp_w_uv[j], gmlp_v_norm[j], gmlp_w_s[j], gmlp_b_s[j], gmlp_w_o[j])
        x = x + y
        x = x + memory_cross_attention(rms_norm(x, xattn_norm[i]), mem_k, mem_v,
                                       xattn_wq[i], xattn_wo[i])
        x = x + 0.5 * swiglu_ffn(rms_norm(x, ffn2_norm[i]), ffn2_w_in[i], ffn2_w_out[i])
    return rms_norm(x, final_norm)
```

```cpp
#include <hip/hip_runtime.h>
#include <hip/hip_cooperative_groups.h>
#include <cstdio>
namespace cg = cooperative_groups;

#ifndef MEGA
#define MEGA 1
#endif
#ifndef PHMASK
#define PHMASK 0xFFFFF
#endif
#define EN(x) ((PHMASK >> (x)) & 1)

#define LAS __attribute__((address_space(3)))
typedef unsigned short bf16_t;
typedef short bf16x8 __attribute__((ext_vector_type(8)));
typedef float f32x4 __attribute__((ext_vector_type(4)));
typedef float f32x2 __attribute__((ext_vector_type(2)));
typedef unsigned u32x4 __attribute__((ext_vector_type(4)));
typedef unsigned u32x2 __attribute__((ext_vector_type(2)));

constexpr int T = 32768, C = 1024, FF = 2816, SEQ = 4096, NB = 8;
constexpr int NRK = 3584;
constexpr int LDS_BYTES = 131072;
constexpr float RMS_EPS = 1e-6f;

constexpr size_t SZ_WIN = (size_t)5632 * 1024 * 2, SZ_WOUT = (size_t)1024 * 2816 * 2, SZ_SQ = (size_t)1024 * 1024 * 2;
constexpr size_t OFF_WIN = 0;
constexpr size_t OFF_WOUT = OFF_WIN + 4 * SZ_WIN;
constexpr size_t OFF_WQ = OFF_WOUT + 4 * SZ_WOUT;
constexpr size_t OFF_WO = OFF_WQ + 2 * SZ_SQ;
constexpr size_t OFF_WMK = OFF_WO + 2 * SZ_SQ;
constexpr size_t OFF_WMV = OFF_WMK + SZ_SQ;
constexpr size_t OFF_WRK = OFF_WMV + SZ_SQ;
constexpr size_t OFF_W2T = OFF_WRK + (size_t)NRK * 2048 * 2;
constexpr size_t OFF_A2T = OFF_W2T + 1024 * 64 * 2;
constexpr size_t OFF_G2T = OFF_A2T + 1024 * 64 * 2;
constexpr size_t OFF_RWO = OFF_G2T + 1024 * 160 * 2;
constexpr size_t OFF_GUV = OFF_RWO + SZ_SQ;
constexpr size_t OFF_GWO = OFF_GUV + (size_t)4096 * 1024 * 2;
constexpr size_t OFF_WS16 = OFF_GWO + (size_t)1024 * 2048 * 2;
constexpr size_t OFF_SSQ = OFF_WS16 + 16 * 128 * 128 * 2;
constexpr size_t OFF_SSQV = OFF_SSQ + (size_t)9 * T * 16 * 4;
constexpr size_t OFF_BONUS = OFF_SSQV + (size_t)T * 32 * 4;
constexpr size_t OFF_GNST = OFF_BONUS + (size_t)T * 16 * 4;
constexpr size_t OFF_MEMN = OFF_GNST + (size_t)T * 16 * 2 * 8;
constexpr size_t OFF_MK = OFF_MEMN + (size_t)2048 * 1024 * 2;
constexpr size_t OFF_VT = OFF_MK + (size_t)2048 * 1024 * 2;
constexpr size_t OFF_XB = OFF_VT + (size_t)2048 * 1024 * 2;
constexpr size_t OFF_BIG = OFF_XB + (size_t)(NB * 4097) * 1024 * 2 + 4096;
constexpr size_t BIG_Y = (size_t)T * NRK * 2;
constexpr size_t BIG_V = (size_t)T * 2048 * 2;
constexpr size_t BIG_O = (size_t)T * 1024 * 2;
constexpr size_t BIG_P = 2 * BIG_O;
constexpr size_t WS_END = OFF_BIG + BIG_Y + (size_t)T * 1024 * 2;
static_assert(WS_END <= (size_t)536870912, "workspace");

struct Params { const float* in[36]; float* out; unsigned char* ws; int ph_lo, ph_hi; };
typedef const __attribute__((address_space(4))) Params* PP;

__device__ __forceinline__ unsigned cvt_pk_bf16(float lo, float hi) { unsigned r; asm("v_cvt_pk_bf16_f32 %0, %1, %2" : "=v"(r) : "v"(lo), "v"(hi)); return r; }
__device__ __forceinline__ float bf_lo(unsigned w) { return __uint_as_float(w << 16); }
__device__ __forceinline__ float bf_hi(unsigned w) { return __uint_as_float(w & 0xffff0000u); }
template <int CTRL> __device__ __forceinline__ float dppf(float x) { return __int_as_float(__builtin_amdgcn_update_dpp(__float_as_int(x), __float_as_int(x), CTRL, 0xf, 0xf, false)); }
__device__ __forceinline__ float allred8(float x) { x += dppf<0xB1>(x); x += dppf<0x4E>(x); x += dppf<0x141>(x); return x; }
__device__ __forceinline__ float allred16(float x) { x = allred8(x); x += dppf<0x140>(x); return x; }
__device__ __forceinline__ float sigmoidf_(float x) { return 1.0f / (1.0f + __expf(-x)); }
__device__ __forceinline__ float tanhf_(float x) { const float e = __expf(-2.0f * fabsf(x)); const float t = (1.0f - e) / (1.0f + e); return x < 0.f ? -t : t; }
__device__ __forceinline__ float gelu_tanh(float x) { const float u = 0.7978845608028654f * (x + 0.044715f * x * x * x); return 0.5f * x * (1.0f + tanhf_(u)); }
__device__ __forceinline__ float ssq16(const float* part) { const f32x4 a = *(const f32x4*)part, b = *(const f32x4*)(part + 4), c = *(const f32x4*)(part + 8), d = *(const f32x4*)(part + 12);
    return (((a[0] + a[1]) + (a[2] + a[3])) + ((b[0] + b[1]) + (b[2] + b[3]))) + (((c[0] + c[1]) + (c[2] + c[3])) + ((d[0] + d[1]) + (d[2] + d[3]))); }
#define LBAR() do { asm volatile("s_waitcnt lgkmcnt(0)" ::: "memory"); __builtin_amdgcn_s_barrier(); asm volatile("" ::: "memory"); } while (0)

namespace pg8 {
constexpr int BM = 256, BK = 64, HALF = 128, HTB = HALF * BK * 2, NXCD = 8, WGM = 8;
__host__ __device__ __forceinline__ int lds_byte(int r, int c) { const int st = (r >> 4) * 2 + (c >> 5), rr = r & 15, cc = c & 31, ob = rr * 64 + cc * 2; return st * 1024 + (ob ^ (((ob >> 9) & 1) << 5)); }
__host__ __device__ __forceinline__ void stage_rc(int b, int& R, int& Cc) { const int st = b / 1024, sb = b % 1024, swz = sb ^ (((sb >> 9) & 1) << 5); R = (st >> 1) * 16 + swz / 64; Cc = (st & 1) * 32 + (swz % 64) / 2; }
__host__ __device__ __forceinline__ int perm32(int rho) { const int n = rho >> 4, i = rho & 15; return 8 * (i >> 2) + 4 * n + (i & 3); }

struct Unit { int pm, pn; };
struct Gemm { const bf16_t* A; const bf16_t* Bt; int M, N, K, lda, ldb; size_t padA; };

struct StaticOrder {
    int nM, nN, nwg, G, c;
    __device__ void init(int M, int N, int G_, int c_) { nM = M / BM; nN = N / BM; nwg = nM * nN; G = G_; c = c_; }
    __device__ bool next(int i, Unit& u) const {
        const long L = (long)i * G + c; if (L >= nwg) return false;
        int wgid = (int)L; { const int q = nwg / NXCD, r = nwg % NXCD, xcd = wgid % NXCD, off = wgid / NXCD; wgid = (xcd < r ? xcd * (q + 1) : r * (q + 1) + (xcd - r) * q) + off; }
        const int nig = WGM * nN, gid = wgid / nig, fm = gid * WGM, gsz = (nM - fm) < WGM ? (nM - fm) : WGM;
        u.pm = fm + ((wgid % nig) % gsz); u.pn = (wgid % nig) / gsz; return true;
    }
};
struct SingleUnit { __device__ bool next(int i, Unit& u) const { u.pm = 0; u.pn = 0; return i == 0; } };

template <class Epi, class Sched>
__device__ __forceinline__ void gemm_phase(LAS unsigned char* lds, const Gemm g, const Sched& S, const Epi& E) {
    int tid_ = threadIdx.x; asm volatile("" : "+v"(tid_));
    const int tid = tid_, wid = __builtin_amdgcn_readfirstlane(tid >> 6), lane = tid & 63, wr = wid >> 2, wc = wid & 3, fr = lane & 15, fq = lane >> 4;
    const int K = g.K, nt = K / BK;
    unsigned voffA[2], voffB[2];
#pragma unroll
    for (int i = 0; i < 2; ++i) { int R, Cc; stage_rc(tid * 16 + i * 8192, R, Cc); const int Rb = Epi::PERM ? ((R & ~31) + perm32(R & 31)) : R;
        voffA[i] = (unsigned)(R * g.lda + Cc) * 2u; voffB[i] = (unsigned)(Rb * g.ldb + Cc) * 2u; }
    const size_t kstep = (size_t)(BK * 2);
    const size_t hstepA = (size_t)HALF * g.lda * 2, hstepB = (size_t)HALF * g.ldb * 2;
    const size_t tstepA = 2 * hstepA, tstepB = 2 * hstepB;
    const unsigned ldsw = (unsigned)wid * 1024u;
    const int aoff = lds_byte(wr * 64 + fr, fq * 8), boff = lds_byte(wc * 32 + fr, fq * 8);
#define PG8_SA(b, h) (((b) * 2 + (h)) * HTB)
#define PG8_SB(b, h) ((4 + (b) * 2 + (h)) * HTB)
#define PG8_STAGE(bufoff, gbase, voff) do { _Pragma("unroll") for (int _i = 0; _i < 2; ++_i) \
        __builtin_amdgcn_global_load_lds((const unsigned*)((const char*)(gbase) + (voff)[_i]), (LAS unsigned*)(lds + (bufoff) + ldsw + _i * 8192), 16, 0, 0); } while (0)
#define PG8_LDA(dst, b, h) do { _Pragma("unroll") for (int m = 0; m < 4; ++m) _Pragma("unroll") for (int k = 0; k < 2; ++k) dst[m][k] = *(const LAS bf16x8*)(lds + PG8_SA(b, h) + aoff + m * 2048 + k * 1024); } while (0)
#define PG8_LDB(dst, b, h) do { _Pragma("unroll") for (int n = 0; n < 2; ++n) _Pragma("unroll") for (int k = 0; k < 2; ++k) dst[n][k] = *(const LAS bf16x8*)(lds + PG8_SB(b, h) + boff + n * 2048 + k * 1024); } while (0)
#define PG8_MMA(ai, bj, At, Bt) do { __builtin_amdgcn_s_setprio(1); _Pragma("unroll") for (int m = 0; m < 4; ++m) _Pragma("unroll") for (int n = 0; n < 2; ++n) _Pragma("unroll") for (int k = 0; k < 2; ++k) \
        acc[ai][bj][m][n] = __builtin_amdgcn_mfma_f32_16x16x32_bf16(Bt[n][k], At[m][k], acc[ai][bj][m][n], 0, 0, 0); __builtin_amdgcn_s_setprio(0); } while (0)
#define PG8_WAIT_V(n) asm volatile("s_waitcnt vmcnt(" #n ")" ::: "memory")
#define PG8_WAIT_L(n) asm volatile("s_waitcnt lgkmcnt(" #n ")" ::: "memory")
#define PG8_BAR __builtin_amdgcn_s_barrier()
#define PG8_SCHED __builtin_amdgcn_sched_barrier(0)
#define PG8_APTR(u) ((const char*)g.A + (size_t)(u).pm * tstepA + (size_t)((u).pm >> 4) * g.padA)
#define PG8_BPTR(u) ((const char*)g.Bt + (size_t)(u).pn * tstepB)
    Unit cur, nxt; int ui = 0;
    if (!S.next(0, cur)) return;
    f32x4 acc[2][2][4][2];
#pragma unroll
    for (int a = 0; a < 2; ++a)
#pragma unroll
        for (int b = 0; b < 2; ++b)
#pragma unroll
            for (int m = 0; m < 4; ++m)
#pragma unroll
                for (int n = 0; n < 2; ++n) acc[a][b][m][n] = (f32x4){0.f, 0.f, 0.f, 0.f};
    bf16x8 At[4][2], B0[2][2], B1[2][2];
    const char* cA = PG8_APTR(cur); const char* cB = PG8_BPTR(cur);
    PG8_STAGE(PG8_SB(0, 0), cB, voffB); PG8_STAGE(PG8_SA(0, 0), cA, voffA); PG8_STAGE(PG8_SB(0, 1), cB + hstepB, voffB); PG8_STAGE(PG8_SA(0, 1), cA + hstepA, voffA);
    if (wr == 1) PG8_BAR;
    PG8_WAIT_V(4); PG8_BAR;
    PG8_STAGE(PG8_SB(1, 0), cB + kstep, voffB); PG8_STAGE(PG8_SA(1, 0), cA + kstep, voffA); PG8_STAGE(PG8_SB(1, 1), cB + hstepB + kstep, voffB);
    PG8_WAIT_V(6); PG8_BAR;
    for (;;) {
        const bool has_next = S.next(ui + 1, nxt);
        const char* nA = has_next ? PG8_APTR(nxt) : cA; const char* nB = has_next ? PG8_BPTR(nxt) : cB;
        for (int t = 0; t < nt; t += 2) {
            const bool last = (t == nt - 2);
            const char* a1 = cA + (size_t)(t + 1) * kstep;
            const char* a2 = last ? nA : cA + (size_t)(t + 2) * kstep; const char* b2 = last ? nB : cB + (size_t)(t + 2) * kstep;
            const char* a3 = a2 + kstep; const char* b3 = b2 + kstep;
            PG8_LDB(B0, 0, 0); PG8_SCHED; PG8_LDA(At, 0, 0); PG8_STAGE(PG8_SA(1, 1), a1 + hstepA, voffA);
            PG8_WAIT_L(8); PG8_BAR; PG8_WAIT_L(0); PG8_MMA(0, 0, At, B0); PG8_BAR; PG8_SCHED;
            PG8_LDB(B1, 0, 1); PG8_STAGE(PG8_SB(0, 0), b2, voffB);
            PG8_BAR; PG8_WAIT_L(0); PG8_MMA(0, 1, At, B1); PG8_BAR;
            PG8_LDA(At, 0, 1); PG8_STAGE(PG8_SA(0, 0), a2, voffA);
            PG8_BAR; PG8_WAIT_L(0); PG8_MMA(1, 0, At, B0); PG8_BAR; PG8_SCHED;
            PG8_STAGE(PG8_SB(0, 1), b2 + hstepB, voffB);
            PG8_WAIT_V(6); PG8_BAR; PG8_MMA(1, 1, At, B1); PG8_BAR;
            PG8_LDB(B0, 1, 0); PG8_SCHED; PG8_LDA(At, 1, 0); PG8_STAGE(PG8_SA(0, 1), a2 + hstepA, voffA);
            PG8_WAIT_L(8); PG8_BAR; PG8_WAIT_L(0); PG8_MMA(0, 0, At, B0); PG8_BAR; PG8_SCHED;
            PG8_LDB(B1, 1, 1); PG8_STAGE(PG8_SB(1, 0), b3, voffB);
            PG8_BAR; PG8_WAIT_L(0); PG8_MMA(0, 1, At, B1); PG8_BAR;
            PG8_LDA(At, 1, 1); PG8_STAGE(PG8_SA(1, 0), a3, voffA);
            PG8_BAR; PG8_WAIT_L(0); PG8_MMA(1, 0, At, B0); PG8_BAR; PG8_SCHED;
            PG8_STAGE(PG8_SB(1, 1), b3 + hstepB, voffB);
            PG8_WAIT_V(6); PG8_BAR; PG8_MMA(1, 1, At, B1); PG8_BAR;
        }
        if constexpr (!Epi::AFTER_DRAIN) { E(acc, cur, wr, wc, fr, fq); }
        if (!has_next) break;
#pragma unroll
        for (int a = 0; a < 2; ++a)
#pragma unroll
            for (int b = 0; b < 2; ++b)
#pragma unroll
                for (int m = 0; m < 4; ++m)
#pragma unroll
                    for (int n = 0; n < 2; ++n) acc[a][b][m][n] = (f32x4){0.f, 0.f, 0.f, 0.f};
        cur = nxt; cA = nA; cB = nB; ++ui;
    }
    PG8_WAIT_V(0);
    if (wr == 0) PG8_BAR;
    PG8_BAR;
    if constexpr (Epi::AFTER_DRAIN) { E.fused(acc, cur, wr, wc, fr, fq, lds, wid, lane); }
#undef PG8_SA
#undef PG8_SB
#undef PG8_STAGE
#undef PG8_LDA
#undef PG8_LDB
#undef PG8_MMA
#undef PG8_WAIT_V
#undef PG8_WAIT_L
#undef PG8_BAR
#undef PG8_SCHED
#undef PG8_APTR
#undef PG8_BPTR
}

typedef f32x4 AccT[2][2][4][2];

struct EpiSwiGLU {
    static constexpr bool PERM = true, AFTER_DRAIN = false;
    bf16_t* H; const float* ssq;
    __device__ __forceinline__ void operator()(const AccT& acc, const Unit& u, int wr, int wc, int fr, int fq) const {
        const int row0 = u.pm * BM + wr * 64 + fr, col0 = u.pn * 128 + wc * 32 + 8 * fq;
#pragma unroll
        for (int ai = 0; ai < 2; ++ai)
#pragma unroll
            for (int m = 0; m < 4; ++m) { const int row = row0 + ai * HALF + m * 16; const float rs = rsqrtf(ssq16(ssq + (size_t)row * 16) * (1.0f / 1024.0f) + RMS_EPS);
                float h[8];
#pragma unroll
                for (int n = 0; n < 2; ++n)
#pragma unroll
                    for (int e = 0; e < 4; ++e) { const float gv = acc[ai][0][m][n][e] * rs, uv = acc[ai][1][m][n][e] * rs; h[n * 4 + e] = gv * sigmoidf_(gv) * uv; }
                u32x4 w; w.x = cvt_pk_bf16(h[0], h[1]); w.y = cvt_pk_bf16(h[2], h[3]); w.z = cvt_pk_bf16(h[4], h[5]); w.w = cvt_pk_bf16(h[6], h[7]);
                *(u32x4*)(H + (size_t)row * FF + col0) = w; asm volatile("" ::: "memory"); }
    }
};
struct EpiResid {
    static constexpr bool PERM = false, AFTER_DRAIN = false;
    const float* xin; float* xout; bf16_t* xb; float* ssq; float alpha;
    __device__ __forceinline__ void operator()(const AccT& acc, const Unit& u, int wr, int wc, int fr, int fq) const {
        const int row0 = u.pm * BM + wr * 64 + fr, col0 = u.pn * BM + wc * 32 + 4 * fq;
#pragma unroll
        for (int ai = 0; ai < 2; ++ai)
#pragma unroll
            for (int m = 0; m < 4; ++m) { const int row = row0 + ai * HALF + m * 16; const size_t off = (size_t)row * C + col0; float s = 0.f;
#pragma unroll
                for (int bj = 0; bj < 2; ++bj)
#pragma unroll
                    for (int n = 0; n < 2; ++n) { const size_t o = off + bj * HALF + n * 16; const f32x4 xv = *(const f32x4*)(xin + o); const f32x4 r = xv + alpha * acc[ai][bj][m][n];
                        *(f32x4*)(xout + o) = r; u32x2 w; w.x = cvt_pk_bf16(r[0], r[1]); w.y = cvt_pk_bf16(r[2], r[3]); *(u32x2*)(xb + o) = w;
                        s += (r[0] * r[0] + r[1] * r[1]) + (r[2] * r[2] + r[3] * r[3]); }
                s += __shfl_xor(s, 16); s += __shfl_xor(s, 32);
                if (fq == 0) ssq[(size_t)row * 16 + u.pn * 4 + wc] = s; asm volatile("" ::: "memory"); }
    }
};
template <int MODE> struct EpiB {
    static constexpr bool PERM = true, AFTER_DRAIN = false;
    bf16_t* O; int ldc; int row_base, col_base; const float* ssq; float* ssqv; bf16_t* O2;
    __device__ __forceinline__ void operator()(const AccT& acc, const Unit& u, int wr, int wc, int fr, int fq) const {
        const int row0 = u.pm * BM + wr * 64 + fr; const int colt = u.pn * BM + wc * 32 + 8 * fq;
#pragma unroll
        for (int ai = 0; ai < 2; ++ai)
#pragma unroll
            for (int m = 0; m < 4; ++m) { const int row = row0 + ai * HALF + m * 16; float rs = 1.0f; float sq = 0.f;
                if (MODE == 1 || MODE == 3) rs = rsqrtf(ssq16(ssq + (size_t)row * 16) * (1.0f / 1024.0f) + RMS_EPS);
#pragma unroll
                for (int bj = 0; bj < 2; ++bj) { const int col = colt + bj * HALF; float v[8];
#pragma unroll
                    for (int n = 0; n < 2; ++n)
#pragma unroll
                        for (int e = 0; e < 4; ++e) v[n * 4 + e] = acc[ai][bj][m][n][e] * rs;
                    if (MODE == 2) { if (col >= 3072 && col < 3136) {
#pragma unroll
                            for (int e = 0; e < 8; ++e) v[e] = tanhf_(v[e]); }
                        else if (col >= 3200 && col < 3360) {
#pragma unroll
                            for (int e = 0; e < 8; ++e) v[e] = sigmoidf_(v[e]); } }
                    if (MODE == 3) {
#pragma unroll
                        for (int e = 0; e < 8; ++e) { v[e] = gelu_tanh(v[e]); sq += v[e] * v[e]; } }
                    u32x4 w; w.x = cvt_pk_bf16(v[0], v[1]); w.y = cvt_pk_bf16(v[2], v[3]); w.z = cvt_pk_bf16(v[4], v[5]); w.w = cvt_pk_bf16(v[6], v[7]);
                    if (MODE == 3) { bf16_t* dst = (col < 2048) ? (O + (size_t)row * 2048 + col) : (O2 + (size_t)row * 2048 + (col - 2048)); *(u32x4*)dst = w; }
                    else *(u32x4*)(O + (size_t)(row_base + row) * ldc + col_base + col) = w; }
                if (MODE == 3) { if (u.pn >= 8) { sq += __shfl_xor(sq, 16); sq += __shfl_xor(sq, 32); if (fq == 0) ssqv[(size_t)row * 32 + (u.pn - 8) * 4 + wc] = sq; } } asm volatile("" ::: "memory"); }
    }
};
struct EpiSoftmax {
    static constexpr bool PERM = true, AFTER_DRAIN = true;
    bf16_t* P;
    __device__ __forceinline__ void fused(AccT& acc, const Unit& u, int wr, int wc, int fr, int fq, LAS unsigned char* lds, int wid, int lane) const {
        LAS float* tab = (LAS float*)lds;
#pragma unroll
        for (int ai = 0; ai < 2; ++ai)
#pragma unroll
            for (int m = 0; m < 4; ++m) { float mx = -3.0e38f;
#pragma unroll
                for (int bj = 0; bj < 2; ++bj)
#pragma unroll
                    for (int n = 0; n < 2; ++n)
#pragma unroll
                        for (int e = 0; e < 4; ++e) mx = fmaxf(mx, acc[ai][bj][m][n][e]);
                mx = fmaxf(mx, __shfl_xor(mx, 16)); mx = fmaxf(mx, __shfl_xor(mx, 32));
                if (fq == 0) tab[(ai * HALF + wr * 64 + m * 16 + fr) * 4 + wc] = mx; }
        LBAR();
        float sums[2][4];
#pragma unroll
        for (int ai = 0; ai < 2; ++ai)
#pragma unroll
            for (int m = 0; m < 4; ++m) { const f32x4 t4 = *(const LAS f32x4*)(tab + (ai * HALF + wr * 64 + m * 16 + fr) * 4);
                const float mx = fmaxf(fmaxf(t4[0], t4[1]), fmaxf(t4[2], t4[3])); float s = 0.f;
#pragma unroll
                for (int bj = 0; bj < 2; ++bj)
#pragma unroll
                    for (int n = 0; n < 2; ++n)
#pragma unroll
                        for (int e = 0; e < 4; ++e) { const float pv = __expf(acc[ai][bj][m][n][e] - mx); acc[ai][bj][m][n][e] = pv; s += pv; }
                s += __shfl_xor(s, 16); s += __shfl_xor(s, 32); sums[ai][m] = s; asm volatile("" ::: "memory"); }
        LBAR();
#pragma unroll
        for (int ai = 0; ai < 2; ++ai)
#pragma unroll
            for (int m = 0; m < 4; ++m) if (fq == 0) tab[(ai * HALF + wr * 64 + m * 16 + fr) * 4 + wc] = sums[ai][m];
        LBAR();
#pragma unroll
        for (int ai = 0; ai < 2; ++ai)
#pragma unroll
            for (int m = 0; m < 4; ++m) { const int r = ai * HALF + wr * 64 + m * 16 + fr; const f32x4 t4 = *(const LAS f32x4*)(tab + r * 4);
                const float inv = 1.0f / ((t4[0] + t4[1]) + (t4[2] + t4[3]));
#pragma unroll
                for (int bj = 0; bj < 2; ++bj) { const f32x4 a = acc[ai][bj][m][0] * inv, b = acc[ai][bj][m][1] * inv;
                    u32x4 w; w.x = cvt_pk_bf16(a[0], a[1]); w.y = cvt_pk_bf16(a[2], a[3]); w.z = cvt_pk_bf16(b[0], b[1]); w.w = cvt_pk_bf16(b[2], b[3]);
                    *(u32x4*)(P + (size_t)r * 256 + bj * HALF + wc * 32 + 8 * fq) = w; } asm volatile("" ::: "memory"); }
        LBAR();
    }
};
}

struct Ctx { int tid, lane, wv, G, bid; LAS unsigned char* lds; };

struct TJob { const float* src; int lds_, K, N, c0; bf16_t* dst; int ldd, rowmap, drow0, dcol0; const float* g; const float* mu; int mode; float cs; };
__device__ __forceinline__ void run_tconv(const Ctx& cx, const TJob& j) {
    LAS float* tile = (LAS float*)cx.lds;
    const int tk = (j.K + 63) >> 6, tn = (j.N + 63) >> 6, ntile = tk * tn;
    for (int t = cx.bid; t < ntile; t += cx.G) {
        const int k0 = (t % tk) * 64, n0 = (t / tk) * 64;
        { const int kr = cx.tid >> 3, nc = (cx.tid & 7) * 8; const int k = k0 + kr, n = n0 + nc;
            float v[8];
            if (k < j.K && n < j.N) { const float* sp = j.src + (size_t)k * j.lds_ + j.c0 + n; const f32x4 a = *(const f32x4*)sp, b = *(const f32x4*)(sp + 4);
                float sc = j.cs; if (j.g) sc *= j.g[k]; if (j.mode == 1) sc *= j.mu[k]; else if (j.mode == 2) sc *= (1.0f - j.mu[k]);
                v[0] = a[0] * sc; v[1] = a[1] * sc; v[2] = a[2] * sc; v[3] = a[3] * sc; v[4] = b[0] * sc; v[5] = b[1] * sc; v[6] = b[2] * sc; v[7] = b[3] * sc; }
            else {
#pragma unroll
                for (int e = 0; e < 8; ++e) v[e] = 0.f; }
#pragma unroll
            for (int e = 0; e < 8; ++e) tile[kr * 65 + nc + e] = v[e]; }
        __syncthreads();
        { const int nr = cx.tid >> 3, kc = (cx.tid & 7) * 8; const int n = n0 + nr, k = k0 + kc;
            if (n < j.N && k < j.K) { float v[8];
#pragma unroll
                for (int e = 0; e < 8; ++e) v[e] = tile[(kc + e) * 65 + nr];
                const int drow = j.drow0 + (j.rowmap ? ((n >> 7) * 256 + (n & 127)) : n);
                u32x4 w; w.x = cvt_pk_bf16(v[0], v[1]); w.y = cvt_pk_bf16(v[2], v[3]); w.z = cvt_pk_bf16(v[4], v[5]); w.w = cvt_pk_bf16(v[6], v[7]);
                *(u32x4*)(j.dst + (size_t)drow * j.ldd + j.dcol0 + k) = w; } }
        __syncthreads();
    }
}
__device__ __forceinline__ bool make_job(int i, PP p, unsigned char* ws, TJob& j) {
    j.g = nullptr; j.mu = nullptr; j.mode = 0; j.cs = 1.0f; j.rowmap = 0; j.drow0 = 0; j.dcol0 = 0; j.c0 = 0;
    if (i < 8) {
        const int bj = i & 1, f = (i >> 1) & 1, l = i >> 2;
        j.src = p->in[f ? 12 : 5] + (size_t)l * 1024 * 5632; j.lds_ = 5632; j.K = 1024; j.N = 2816; j.c0 = bj * 2816;
        j.dst = (bf16_t*)(ws + OFF_WIN + (size_t)(l * 2 + f) * SZ_WIN); j.ldd = 1024; j.rowmap = 1; j.drow0 = bj * 128; j.g = p->in[f ? 11 : 4] + l * 1024; return true; }
    i -= 8;
    if (i < 4) {
        const int f = i & 1, l = i >> 1;
        j.src = p->in[f ? 13 : 6] + (size_t)l * 2816 * 1024; j.lds_ = 1024; j.K = 2816; j.N = 1024; j.dst = (bf16_t*)(ws + OFF_WOUT + (size_t)(l * 2 + f) * SZ_WOUT); j.ldd = 2816; return true; }
    i -= 4;
    if (i < 4) {
        const int o = i & 1, l = i >> 1;
        j.src = p->in[o ? 10 : 9] + (size_t)l * 1024 * 1024; j.lds_ = 1024; j.K = 1024; j.N = 1024; j.dst = (bf16_t*)(ws + (o ? OFF_WO : OFF_WQ) + (size_t)l * SZ_SQ); j.ldd = 1024;
        if (!o) { j.g = p->in[8] + l * 1024; j.cs = 0.0625f; } return true; }
    i -= 4;
    if (i < 2) {
        j.src = p->in[3]; j.lds_ = 2048; j.K = 1024; j.N = 1024; j.c0 = i * 1024; j.dst = (bf16_t*)(ws + (i ? OFF_WMV : OFF_WMK)); j.ldd = 1024; j.g = p->in[2]; return true; }
    i -= 2;
    if (i < 12) {
        const int half = i & 1, part = i >> 1;
        if (part < 3) { j.src = p->in[15]; j.lds_ = 3072; j.N = 1024; j.c0 = part * 1024; j.drow0 = part * 1024; }
        else if (part == 3) { j.src = p->in[17]; j.lds_ = 64; j.N = 64; j.drow0 = 3072; }
        else if (part == 4) { j.src = p->in[20]; j.lds_ = 64; j.N = 64; j.drow0 = 3136; }
        else { j.src = p->in[22]; j.lds_ = 160; j.N = 160; j.drow0 = 3200; }
        const int mi = part == 0 ? 0 : part == 1 ? 2 : part == 2 ? 3 : part == 3 ? 1 : part == 4 ? 4 : 5;
        j.K = 1024; j.dst = (bf16_t*)(ws + OFF_WRK); j.ldd = 2048; j.dcol0 = half ? 1024 : 0; j.g = p->in[7]; j.mu = p->in[14] + mi * 1024; j.mode = half ? 2 : 1; return true; }
    i -= 12;
    if (i == 0) { j.src = p->in[18]; j.lds_ = 1024; j.K = 64; j.N = 1024; j.dst = (bf16_t*)(ws + OFF_W2T); j.ldd = 64; return true; }
    if (i == 1) { j.src = p->in[21]; j.lds_ = 1024; j.K = 64; j.N = 1024; j.dst = (bf16_t*)(ws + OFF_A2T); j.ldd = 64; return true; }
    if (i == 2) { j.src = p->in[23]; j.lds_ = 1024; j.K = 160; j.N = 1024; j.dst = (bf16_t*)(ws + OFF_G2T); j.ldd = 160; return true; }
    if (i == 3) { j.src = p->in[29]; j.lds_ = 1024; j.K = 1024; j.N = 1024; j.dst = (bf16_t*)(ws + OFF_RWO); j.ldd = 1024; return true; }
    if (i == 4) { j.src = p->in[30]; j.lds_ = 4096; j.K = 1024; j.N = 4096; j.dst = (bf16_t*)(ws + OFF_GUV); j.ldd = 1024; j.g = p->in[7] + 1024; return true; }
    if (i == 5) { j.src = p->in[34]; j.lds_ = 1024; j.K = 2048; j.N = 1024; j.dst = (bf16_t*)(ws + OFF_GWO); j.ldd = 2048; return true; }
    return false;
}

__device__ __forceinline__ void phase_prep(const Ctx& cx, PP p, unsigned char* ws) {
    { const float* w = p->in[32]; bf16_t* o = (bf16_t*)(ws + OFF_WS16); for (int i = cx.bid * 512 + cx.tid; i < 16 * 128 * 128; i += cx.G * 512) { const int s = i & 127, t = (i >> 7) & 127; o[i] = (bf16_t)(cvt_pk_bf16(s <= t ? w[i] : 0.f, 0.f) & 0xffffu); } }
    const int gw = cx.bid * 8 + cx.wv, nw = cx.G * 8;
    { const float* x = p->in[0]; bf16_t* xb = (bf16_t*)(ws + OFF_XB); float* ssq0 = (float*)(ws + OFF_SSQ);
        for (int r = gw; r < T; r += nw) { float s = 0.f;
#pragma unroll
            for (int i = 0; i < 4; ++i) { const size_t o = (size_t)r * C + i * 256 + cx.lane * 4; const f32x4 v = *(const f32x4*)(x + o);
                u32x2 w; w.x = cvt_pk_bf16(v[0], v[1]); w.y = cvt_pk_bf16(v[2], v[3]); *(u32x2*)(xb + o) = w; s += (v[0] * v[0] + v[1] * v[1]) + (v[2] * v[2] + v[3] * v[3]); }
#pragma unroll
            for (int o = 32; o >= 1; o >>= 1) s += __shfl_xor(s, o);
            if (cx.lane < 16) ssq0[(size_t)r * 16 + cx.lane] = cx.lane == 0 ? s : 0.f; } }
    { const float* x = p->in[1]; bf16_t* xb = (bf16_t*)(ws + OFF_MEMN);
        for (int r = gw; r < 2048; r += nw) { float s = 0.f; f32x4 v[4];
#pragma unroll
            for (int i = 0; i < 4; ++i) { v[i] = *(const f32x4*)(x + (size_t)r * C + i * 256 + cx.lane * 4); s += (v[i][0] * v[i][0] + v[i][1] * v[i][1]) + (v[i][2] * v[i][2] + v[i][3] * v[i][3]); }
#pragma unroll
            for (int o = 32; o >= 1; o >>= 1) s += __shfl_xor(s, o);
            const float rs = rsqrtf(s * (1.0f / 1024.0f) + RMS_EPS);
#pragma unroll
            for (int i = 0; i < 4; ++i) { u32x2 w; w.x = cvt_pk_bf16(v[i][0] * rs, v[i][1] * rs); w.y = cvt_pk_bf16(v[i][2] * rs, v[i][3] * rs); *(u32x2*)(xb + (size_t)r * C + i * 256 + cx.lane * 4) = w; } } }
    for (int i = 0;; ++i) { TJob j; if (!make_job(i, p, ws, j)) break; run_tconv(cx, j); }
}
__device__ __forceinline__ void phase_hn(const Ctx& cx, PP p, unsigned char* ws) {
    const float* x = p->out; bf16_t* hn = (bf16_t*)(ws + OFF_XB); const float* ssq = (const float*)(ws + OFF_SSQ) + (size_t)1 * T * 16;
    const int gw = cx.bid * 8 + cx.wv, nw = cx.G * 8;
    for (int r = gw; r < T; r += nw) { const int b = r >> 12, s = r & 4095; const float rs = rsqrtf(ssq16(ssq + (size_t)r * 16) * (1.0f / 1024.0f) + RMS_EPS);
        bf16_t* dst = hn + (size_t)(b * 4097 + 1 + s) * C;
#pragma unroll
        for (int i = 0; i < 4; ++i) { const int c = i * 256 + cx.lane * 4; const f32x4 v = *(const f32x4*)(x + (size_t)r * C + c);
            u32x2 w; w.x = cvt_pk_bf16(v[0] * rs, v[1] * rs); w.y = cvt_pk_bf16(v[2] * rs, v[3] * rs); *(u32x2*)(dst + c) = w;
            if (s == 0) { u32x2 z; z.x = 0u; z.y = 0u; *(u32x2*)(dst - C + c) = z; } } }
}
__device__ __forceinline__ void phase_final(const Ctx& cx, PP p, unsigned char* ws) {
    float* x = p->out; const float* ssq = (const float*)(ws + OFF_SSQ) + (size_t)8 * T * 16; const float* gf = p->in[35];
    const int gw = cx.bid * 8 + cx.wv, nw = cx.G * 8;
    for (int r = gw; r < T; r += nw) { const float rs = rsqrtf(ssq16(ssq + (size_t)r * 16) * (1.0f / 1024.0f) + RMS_EPS);
#pragma unroll
        for (int i = 0; i < 4; ++i) { const int c = i * 256 + cx.lane * 4; f32x4 v = *(const f32x4*)(x + (size_t)r * C + c); const f32x4 gv = *(const f32x4*)(gf + c);
            v = v * rs * gv; *(f32x4*)(x + (size_t)r * C + c) = v; } }
}

__device__ __forceinline__ void phase_scan(const Ctx& cx, PP p, unsigned char* ws) {
    const bf16_t* RK = (const bf16_t*)(ws + OFF_BIG); bf16_t* Y = (bf16_t*)(ws + OFF_BIG + BIG_Y); bf16_t* Gt = (bf16_t*)(ws + OFF_XB);
    float* bonus = (float*)(ws + OFF_BONUS); f32x2* gnst = (f32x2*)(ws + OFF_GNST);
    const bf16_t* W2T = (const bf16_t*)(ws + OFF_W2T); const bf16_t* A2T = (const bf16_t*)(ws + OFF_A2T); const bf16_t* G2T = (const bf16_t*)(ws + OFF_G2T);
    LAS float* sW = (LAS float*)cx.lds; LAS float* sA = sW + 2048; LAS float* sG = sA + 2048; LAS float* sR = sG + 2048; LAS float* sK = sR + 2048;
    LAS float* sV = sK + 2048; LAS float* sKK = sV + 2048; LAS float* sB = sKK + 2048; LAS float* sY = sB + 2048;
    const int tid = cx.tid, lane = cx.lane, wv = cx.wv;
    const int rb = wv & 1, cb = wv >> 1, fr = lane & 15, fq = lane >> 4;
    const int tl2 = tid >> 4, c4 = (tid & 15) * 4;
    const int irow = (wv & 3) * 8 + (lane >> 3), seg = lane & 7;
    for (int unit = cx.bid; unit < 256; unit += cx.G) {
        const int chain = unit >> 1, half = unit & 1, b = chain >> 4, h = chain & 15;
        const int ch = h * 64 + cb * 16 + fr;
        bf16x8 bw[2], ba[2], bg[5];
#pragma unroll
        for (int ks = 0; ks < 2; ++ks) { bw[ks] = *(const bf16x8*)(W2T + (size_t)ch * 64 + ks * 32 + fq * 8); ba[ks] = *(const bf16x8*)(A2T + (size_t)ch * 64 + ks * 32 + fq * 8); }
#pragma unroll
        for (int ks = 0; ks < 5; ++ks) bg[ks] = *(const bf16x8*)(G2T + (size_t)ch * 160 + ks * 32 + fq * 8);
        const float w0c = p->in[16][ch], a0c = p->in[19][ch];
        const int chan2 = h * 64 + c4;
        const f32x4 kk4 = *(const f32x4*)(p->in[24] + chan2), ka4 = *(const f32x4*)(p->in[25] + chan2), rk4 = *(const f32x4*)(p->in[26] + chan2);
        f32x2 st[4];
#pragma unroll
        for (int q = 0; q < 4; ++q) st[q] = (f32x2){0.f, 0.f};
        const int tok0 = b * SEQ;
        bf16x8 aw[2], aa[2], ag[5]; u32x2 rr, kr, vr;
        { const bf16_t* lp = RK + (size_t)(tok0 + rb * 16 + fr) * NRK + 3072 + fq * 8;
#pragma unroll
            for (int ks = 0; ks < 2; ++ks) { aw[ks] = *(const bf16x8*)(lp + ks * 32); aa[ks] = *(const bf16x8*)(lp + 64 + ks * 32); }
#pragma unroll
            for (int ks = 0; ks < 5; ++ks) ag[ks] = *(const bf16x8*)(lp + 128 + ks * 32);
            const bf16_t* rp = RK + (size_t)(tok0 + tl2) * NRK + chan2; rr = *(const u32x2*)rp; kr = *(const u32x2*)(rp + 1024); vr = *(const u32x2*)(rp + 2048); }
        for (int chunk = 0; chunk < SEQ / 32; ++chunk) {
            const int t0 = tok0 + chunk * 32;
            { f32x4 cw = (f32x4){0.f, 0.f, 0.f, 0.f}, ca = cw, cgv = cw;
#pragma unroll
                for (int ks = 0; ks < 2; ++ks) { cw = __builtin_amdgcn_mfma_f32_16x16x32_bf16(aw[ks], bw[ks], cw, 0, 0, 0); ca = __builtin_amdgcn_mfma_f32_16x16x32_bf16(aa[ks], ba[ks], ca, 0, 0, 0); }
#pragma unroll
                for (int ks = 0; ks < 5; ++ks) cgv = __builtin_amdgcn_mfma_f32_16x16x32_bf16(ag[ks], bg[ks], cgv, 0, 0, 0);
#pragma unroll
                for (int e = 0; e < 4; ++e) { const int o = (rb * 16 + fq * 4 + e) * 64 + cb * 16 + fr;
                    const float z = -(w0c + cw[e]); const float sp = fmaxf(z, 0.f) + __logf(1.0f + __expf(-fabsf(z)));
                    sW[o] = __expf(-__expf(-sp - 0.5f)); sA[o] = sigmoidf_(a0c + ca[e]); sG[o] = cgv[e]; } }
            LBAR();
            { const f32x4 a4 = *(const LAS f32x4*)(sA + tl2 * 64 + c4), g4 = *(const LAS f32x4*)(sG + tl2 * 64 + c4);
                const f32x4 r4 = (f32x4){bf_lo(rr.x), bf_hi(rr.x), bf_lo(rr.y), bf_hi(rr.y)}, k4 = (f32x4){bf_lo(kr.x), bf_hi(kr.x), bf_lo(kr.y), bf_hi(kr.y)}, v4 = (f32x4){bf_lo(vr.x), bf_hi(vr.x), bf_lo(vr.y), bf_hi(vr.y)};
                f32x4 kk = k4 * kk4; float s = (kk[0] * kk[0] + kk[1] * kk[1]) + (kk[2] * kk[2] + kk[3] * kk[3]); s = allred16(s);
                kk = kk * (1.0f / fmaxf(sqrtf(s), 1e-12f));
                const f32x4 kn = k4 * (1.0f + (a4 - 1.0f) * ka4); const f32x4 bb = kk * a4;
                float bo = (r4[0] * kn[0] * rk4[0] + r4[1] * kn[1] * rk4[1]) + (r4[2] * kn[2] * rk4[2] + r4[3] * kn[3] * rk4[3]); bo = allred16(bo);
                const int o = tl2 * 64 + c4;
                *(LAS f32x4*)(sR + o) = r4; *(LAS f32x4*)(sK + o) = kn; *(LAS f32x4*)(sV + o) = v4; *(LAS f32x4*)(sKK + o) = kk; *(LAS f32x4*)(sB + o) = bb;
                if (half == 0) { if ((tid & 15) == 0) bonus[(size_t)(t0 + tl2) * 16 + h] = bo; }
                if ((c4 >> 5) == half) { u32x2 w; w.x = cvt_pk_bf16(g4[0], g4[1]); w.y = cvt_pk_bf16(g4[2], g4[3]); *(u32x2*)(Gt + (size_t)(t0 + tl2) * C + chan2) = w; } }
            if (chunk + 1 < SEQ / 32) { const bf16_t* lp = RK + (size_t)(t0 + 32 + rb * 16 + fr) * NRK + 3072 + fq * 8;
#pragma unroll
                for (int ks = 0; ks < 2; ++ks) { aw[ks] = *(const bf16x8*)(lp + ks * 32); aa[ks] = *(const bf16x8*)(lp + 64 + ks * 32); }
#pragma unroll
                for (int ks = 0; ks < 5; ++ks) ag[ks] = *(const bf16x8*)(lp + 128 + ks * 32);
                const bf16_t* rp = RK + (size_t)(t0 + 32 + tl2) * NRK + chan2; rr = *(const u32x2*)rp; kr = *(const u32x2*)(rp + 1024); vr = *(const u32x2*)(rp + 2048); }
            LBAR();
            if (wv < 4) {
#pragma unroll 2
                for (int tl = 0; tl < 32; ++tl) { const int o = tl * 64 + seg * 8;
                    const f32x4 w0 = *(const LAS f32x4*)(sW + o), w1 = *(const LAS f32x4*)(sW + o + 4), q0 = *(const LAS f32x4*)(sKK + o), q1 = *(const LAS f32x4*)(sKK + o + 4);
                    const f32x4 b0 = *(const LAS f32x4*)(sB + o), b1 = *(const LAS f32x4*)(sB + o + 4), k0 = *(const LAS f32x4*)(sK + o), k1 = *(const LAS f32x4*)(sK + o + 4);
                    const f32x4 r0 = *(const LAS f32x4*)(sR + o), r1 = *(const LAS f32x4*)(sR + o + 4); const float vi = sV[tl * 64 + half * 32 + irow];
                    f32x2 sa2 = st[0] * (f32x2){q0[0], q0[1]}; sa2 += st[1] * (f32x2){q0[2], q0[3]}; sa2 += st[2] * (f32x2){q1[0], q1[1]}; sa2 += st[3] * (f32x2){q1[2], q1[3]};
                    float sa = allred8(sa2[0] + sa2[1]); const float nsa = -sa; const f32x2 nsa2 = (f32x2){nsa, nsa}, vi2 = (f32x2){vi, vi};
                    st[0] = st[0] * (f32x2){w0[0], w0[1]} + vi2 * (f32x2){k0[0], k0[1]}; st[1] = st[1] * (f32x2){w0[2], w0[3]} + vi2 * (f32x2){k0[2], k0[3]};
                    st[2] = st[2] * (f32x2){w1[0], w1[1]} + vi2 * (f32x2){k1[0], k1[1]}; st[3] = st[3] * (f32x2){w1[2], w1[3]} + vi2 * (f32x2){k1[2], k1[3]};
                    st[0] += nsa2 * (f32x2){b0[0], b0[1]}; st[1] += nsa2 * (f32x2){b0[2], b0[3]}; st[2] += nsa2 * (f32x2){b1[0], b1[1]}; st[3] += nsa2 * (f32x2){b1[2], b1[3]};
                    f32x2 y2 = st[0] * (f32x2){r0[0], r0[1]}; y2 += st[1] * (f32x2){r0[2], r0[3]}; y2 += st[2] * (f32x2){r1[0], r1[1]}; y2 += st[3] * (f32x2){r1[2], r1[3]};
                    const float y = allred8(y2[0] + y2[1]);
                    if (seg == 0) sY[tl * 32 + irow] = y; } }
            LBAR();
            { const int i2 = (tid & 15) * 2; const float y0 = sY[tl2 * 32 + i2], y1 = sY[tl2 * 32 + i2 + 1];
                *(unsigned*)(Y + (size_t)(t0 + tl2) * C + h * 64 + half * 32 + i2) = cvt_pk_bf16(y0, y1);
                const float s1 = allred16(y0 + y1), s2 = allred16(y0 * y0 + y1 * y1);
                if ((tid & 15) == 0) gnst[((size_t)(t0 + tl2) * 16 + h) * 2 + half] = (f32x2){s1, s2}; }
        }
        LBAR();
    }
}
__device__ __forceinline__ void phase_post(const Ctx& cx, PP p, unsigned char* ws) {
    const bf16_t* RK = (const bf16_t*)(ws + OFF_BIG); bf16_t* Y = (bf16_t*)(ws + OFF_BIG + BIG_Y); const bf16_t* Gt = (const bf16_t*)(ws + OFF_XB);
    const float* bonus = (const float*)(ws + OFF_BONUS); const f32x4* gnst = (const f32x4*)(ws + OFF_GNST);
    const float* lnw = p->in[27]; const float* lnb = p->in[28];
    for (int i = cx.bid * 512 + cx.tid; i < T * 128; i += cx.G * 512) {
        const int t = i >> 7, c8 = (i & 127) * 8, h = c8 >> 6;
        const f32x4 stt = gnst[(size_t)t * 16 + h]; const float mean = (stt[0] + stt[2]) * (1.0f / 64.0f); const float var = fmaxf((stt[1] + stt[3]) * (1.0f / 64.0f) - mean * mean, 0.f);
        const float rs = rsqrtf(var + 64e-5f); const float bo = bonus[(size_t)t * 16 + h];
        const u32x4 yv = *(const u32x4*)(Y + (size_t)t * C + c8), gv = *(const u32x4*)(Gt + (size_t)t * C + c8), vv = *(const u32x4*)(RK + (size_t)t * NRK + 2048 + c8);
        const f32x4 lw0 = *(const f32x4*)(lnw + c8), lw1 = *(const f32x4*)(lnw + c8 + 4), lb0 = *(const f32x4*)(lnb + c8), lb1 = *(const f32x4*)(lnb + c8 + 4);
        float o[8];
#pragma unroll
        for (int e = 0; e < 4; ++e) { const unsigned yw = yv[e], gw = gv[e], vw = vv[e];
            const float l0 = e < 2 ? lw0[2 * e] : lw1[2 * e - 4], l1 = e < 2 ? lw0[2 * e + 1] : lw1[2 * e - 3], c0 = e < 2 ? lb0[2 * e] : lb1[2 * e - 4], c1 = e < 2 ? lb0[2 * e + 1] : lb1[2 * e - 3];
            o[2 * e] = ((bf_lo(yw) - mean) * rs * l0 + c0 + bo * bf_lo(vw)) * bf_lo(gw);
            o[2 * e + 1] = ((bf_hi(yw) - mean) * rs * l1 + c1 + bo * bf_hi(vw)) * bf_hi(gw); }
        u32x4 w; w.x = cvt_pk_bf16(o[0], o[1]); w.y = cvt_pk_bf16(o[2], o[3]); w.z = cvt_pk_bf16(o[4], o[5]); w.w = cvt_pk_bf16(o[6], o[7]);
        *(u32x4*)(Y + (size_t)t * C + c8) = w;
    }
}
__device__ __forceinline__ void phase_spatial(const Ctx& cx, PP p, unsigned char* ws) {
    bf16_t* U = (bf16_t*)(ws + OFF_BIG); const bf16_t* V = (const bf16_t*)(ws + OFF_BIG + BIG_V); const bf16_t* WS16 = (const bf16_t*)(ws + OFF_WS16);
    const float* ssqv = (const float*)(ws + OFF_SSQV); const float* vnorm = p->in[31]; const float* bs = p->in[33];
    LAS unsigned char* sAw = cx.lds;
    LAS unsigned char* sVt = cx.lds + 128 * 272;
    const int tid = cx.tid, lane = cx.lane, wv = cx.wv, fr = lane & 15, fq = lane >> 4;
    int gl = -1;
    for (int unit = cx.bid; unit < 4096; unit += cx.G) {
        const int g = unit & 15, bc = unit >> 4; const int tok0 = bc * 128;
        LBAR();
        if (g != gl) { gl = g;
#pragma unroll
            for (int it = 0; it < 4; ++it) { const int idx = tid + it * 512, t = idx >> 4, sg = idx & 15; const u32x4 w = *(const u32x4*)(WS16 + (size_t)g * 16384 + t * 128 + sg * 8); *(LAS u32x4*)(sAw + t * 272 + sg * 16) = w; } }
#pragma unroll
        for (int it = 0; it < 4; ++it) { const int idx = tid + it * 512, s = idx >> 4, dg = idx & 15;
            const u32x4 w = *(const u32x4*)(V + (size_t)(tok0 + s) * 2048 + g * 128 + dg * 8); const float rs = rsqrtf((ssq16(ssqv + (size_t)(tok0 + s) * 32) + ssq16(ssqv + (size_t)(tok0 + s) * 32 + 16)) * (1.0f / 2048.0f) + RMS_EPS);
            LAS unsigned* d = (LAS unsigned*)(sVt + s * 260 + dg * 16);
            d[0] = cvt_pk_bf16(bf_lo(w.x) * rs, bf_hi(w.x) * rs); d[1] = cvt_pk_bf16(bf_lo(w.y) * rs, bf_hi(w.y) * rs); d[2] = cvt_pk_bf16(bf_lo(w.z) * rs, bf_hi(w.z) * rs); d[3] = cvt_pk_bf16(bf_lo(w.w) * rs, bf_hi(w.w) * rs); }
        LBAR();
        bf16x8 bf[4];
#pragma unroll
        for (int ks = 0; ks < 4; ++ks)
#pragma unroll
            for (int e = 0; e < 8; ++e) bf[ks][e] = (short)*(const LAS unsigned short*)(sVt + (ks * 32 + fq * 8 + e) * 260 + (wv * 16 + fr) * 2);
        const int d4 = g * 128 + wv * 16 + fq * 4; const f32x4 vn4 = *(const f32x4*)(vnorm + d4);
#pragma unroll
        for (int m = 0; m < 8; ++m) { f32x4 acc = (f32x4){0.f, 0.f, 0.f, 0.f};
#pragma unroll
            for (int ks = 0; ks < 4; ++ks) if (ks <= m / 2) { const bf16x8 af = *(const LAS bf16x8*)(sAw + (m * 16 + fr) * 272 + (ks * 32 + fq * 8) * 2); acc = __builtin_amdgcn_mfma_f32_16x16x32_bf16(bf[ks], af, acc, 0, 0, 0); }
            const int t = m * 16 + fr; const float bsv = bs[g * 128 + t]; bf16_t* up = U + (size_t)(tok0 + t) * 2048 + d4; const u32x2 uw = *(const u32x2*)up;
            const f32x4 sv = acc * vn4 + bsv; u32x2 w; w.x = cvt_pk_bf16(bf_lo(uw.x) * sv[0], bf_hi(uw.x) * sv[1]); w.y = cvt_pk_bf16(bf_lo(uw.y) * sv[2], bf_hi(uw.y) * sv[3]); *(u32x2*)up = w; }
    }
    LBAR();
}
__device__ __forceinline__ void phase_xattn(const Ctx& cx, PP p, unsigned char* ws) {
    const bf16_t* Q = (const bf16_t*)(ws + OFF_BIG); bf16_t* O = (bf16_t*)(ws + OFF_BIG + BIG_O); bf16_t* P = (bf16_t*)(ws + OFF_BIG + BIG_P) + (size_t)cx.bid * 65536;
    const bf16_t* MK = (const bf16_t*)(ws + OFF_MK); const bf16_t* VT = (const bf16_t*)(ws + OFF_VT);
    for (int unit = cx.bid; unit < 512; unit += cx.G) {
        const int pm = unit >> 2, h = unit & 3, b = pm >> 4; int kk = 256; asm volatile("" : "+s"(kk));
        { pg8::Gemm g{Q + (size_t)pm * 256 * C + h * 256, MK + (size_t)b * 256 * C + h * 256, 256, 256, kk, C, C, 0}; pg8::SingleUnit S; pg8::EpiSoftmax E{P};
            pg8::gemm_phase<pg8::EpiSoftmax, pg8::SingleUnit>(cx.lds, g, S, E); }
        __syncthreads();
        { pg8::Gemm g{P, VT + (size_t)h * 256 * 2048 + b * 256, 256, 256, kk, 256, 2048, 0}; pg8::SingleUnit S; pg8::EpiB<0> E{O, C, pm * 256, h * 256, nullptr, nullptr, nullptr};
            pg8::gemm_phase<pg8::EpiB<0>, pg8::SingleUnit>(cx.lds, g, S, E); }
        __syncthreads();
    }
}

enum { OP_PREP, OP_MEMKV_FFNIN, OP_FFN_IN, OP_FFN_OUT, OP_HN, OP_RWKV_PROJ, OP_SCAN, OP_POST, OP_RWKV_OUT, OP_XQ, OP_XATT, OP_XO, OP_G1, OP_SPATIAL, OP_G3, OP_FINAL };
constexpr int NPHASE = 24;

__global__ void __launch_bounds__(512, 2) fwd_kernel(Params p_) {
    extern __shared__ __attribute__((aligned(16))) unsigned char smem[];
    cg::grid_group grid = cg::this_grid();
    for (int ph = p_.ph_lo; ph < p_.ph_hi; ++ph) {
        PP p = (PP)__builtin_amdgcn_kernarg_segment_ptr(); asm volatile("" : "+s"(p));
        int tid_ = threadIdx.x; asm volatile("" : "+v"(tid_));
        Ctx cx; cx.tid = tid_; cx.lane = cx.tid & 63; cx.wv = __builtin_amdgcn_readfirstlane(cx.tid >> 6); cx.G = gridDim.x; cx.bid = blockIdx.x; cx.lds = (LAS unsigned char*)smem;
        unsigned char* ws = p->ws;
        float* ssqb = (float*)(ws + OFF_SSQ);
        bf16_t* XB = (bf16_t*)(ws + OFF_XB); bf16_t* BIG = (bf16_t*)(ws + OFF_BIG);
        int op, l = 0, f = 0;
        switch (ph) {
            case 0: op = OP_PREP; break;
            case 1: op = OP_MEMKV_FFNIN; break;
            case 2: op = OP_FFN_OUT; break;
            case 3: op = OP_HN; break;
            case 4: op = OP_RWKV_PROJ; break;
            case 5: op = OP_SCAN; break;
            case 6: op = OP_POST; break;
            case 7: op = OP_RWKV_OUT; break;
            case 8: op = OP_XQ; break;
            case 9: op = OP_XATT; break;
            case 10: op = OP_XO; break;
            case 11: op = OP_FFN_IN; f = 1; break;
            case 12: op = OP_FFN_OUT; f = 1; break;
            case 13: op = OP_FFN_IN; l = 1; break;
            case 14: op = OP_FFN_OUT; l = 1; break;
            case 15: op = OP_G1; l = 1; break;
            case 16: op = OP_SPATIAL; l = 1; break;
            case 17: op = OP_G3; l = 1; break;
            case 18: op = OP_XQ; l = 1; break;
            case 19: op = OP_XATT; l = 1; break;
            case 20: op = OP_XO; l = 1; break;
            case 21: op = OP_FFN_IN; l = 1; f = 1; break;
            case 22: op = OP_FFN_OUT; l = 1; f = 1; break;
            default: op = OP_FINAL; break;
        }
        if (EN(OP_PREP) && op == OP_PREP) phase_prep(cx, p, ws);
        if (EN(OP_MEMKV_FFNIN) && op == OP_MEMKV_FFNIN) {
            { pg8::Gemm g{(const bf16_t*)(ws + OFF_MEMN), (const bf16_t*)(ws + OFF_WMK), 2048, 1024, 1024, 1024, 1024, 0}; pg8::StaticOrder S; S.init(2048, 1024, cx.G, cx.bid);
                pg8::EpiB<0> E{(bf16_t*)(ws + OFF_MK), 1024, 0, 0, nullptr, nullptr, nullptr}; pg8::gemm_phase<pg8::EpiB<0>, pg8::StaticOrder>(cx.lds, g, S, E); }
            { pg8::Gemm g{(const bf16_t*)(ws + OFF_WMV), (const bf16_t*)(ws + OFF_MEMN), 1024, 2048, 1024, 1024, 1024, 0}; pg8::StaticOrder S; S.init(1024, 2048, cx.G, (cx.bid + cx.G / 2) % cx.G);
                pg8::EpiB<0> E{(bf16_t*)(ws + OFF_VT), 2048, 0, 0, nullptr, nullptr, nullptr}; pg8::gemm_phase<pg8::EpiB<0>, pg8::StaticOrder>(cx.lds, g, S, E); }
        }
        if (EN(OP_FFN_IN) && (op == OP_MEMKV_FFNIN || op == OP_FFN_IN)) {
            pg8::Gemm g{XB, (const bf16_t*)(ws + OFF_WIN + (size_t)(l * 2 + f) * SZ_WIN), T, 5632, 1024, 1024, 1024, 0}; pg8::StaticOrder S; S.init(T, 5632, cx.G, cx.bid);
            pg8::EpiSwiGLU E{BIG, ssqb + (size_t)(l * 4 + (f ? 3 : 0)) * T * 16}; pg8::gemm_phase<pg8::EpiSwiGLU, pg8::StaticOrder>(cx.lds, g, S, E);
        }
        if (EN(OP_FFN_OUT) && (op == OP_FFN_OUT || op == OP_RWKV_OUT || op == OP_XO || op == OP_G3)) {
            const bf16_t* A; const bf16_t* Bt; int K; float alpha = 1.0f; int so; const float* xin = p->out;
            if (op == OP_FFN_OUT) { A = BIG; Bt = (const bf16_t*)(ws + OFF_WOUT + (size_t)(l * 2 + f) * SZ_WOUT); K = FF; alpha = 0.5f; so = l * 4 + (f ? 4 : 1); if (l == 0 && f == 0) xin = p->in[0]; }
            else if (op == OP_RWKV_OUT) { A = (const bf16_t*)(ws + OFF_BIG + BIG_Y); Bt = (const bf16_t*)(ws + OFF_RWO); K = 1024; so = 2; }
            else if (op == OP_XO) { A = (const bf16_t*)(ws + OFF_BIG + BIG_O); Bt = (const bf16_t*)(ws + OFF_WO + (size_t)l * SZ_SQ); K = 1024; so = l * 4 + 3; }
            else { A = BIG; Bt = (const bf16_t*)(ws + OFF_GWO); K = 2048; so = 6; }
            pg8::Gemm g{A, Bt, T, 1024, K, K, K, 0}; pg8::StaticOrder S; S.init(T, 1024, cx.G, cx.bid);
            pg8::EpiResid E{xin, p->out, XB, ssqb + (size_t)so * T * 16, alpha}; pg8::gemm_phase<pg8::EpiResid, pg8::StaticOrder>(cx.lds, g, S, E);
        }
        if (EN(OP_HN) && op == OP_HN) phase_hn(cx, p, ws);
        if (EN(OP_RWKV_PROJ) && op == OP_RWKV_PROJ) {
            pg8::Gemm g{XB, (const bf16_t*)(ws + OFF_WRK), T, NRK, 2048, 1024, 2048, (size_t)1024 * 2}; pg8::StaticOrder S; S.init(T, NRK, cx.G, cx.bid);
            pg8::EpiB<2> E{BIG, NRK, 0, 0, nullptr, nullptr, nullptr}; pg8::gemm_phase<pg8::EpiB<2>, pg8::StaticOrder>(cx.lds, g, S, E);
        }
        if (EN(OP_SCAN) && op == OP_SCAN) phase_scan(cx, p, ws);
        if (EN(OP_POST) && op == OP_POST) phase_post(cx, p, ws);
        if (EN(OP_XQ) && op == OP_XQ) {
            pg8::Gemm g{XB, (const bf16_t*)(ws + OFF_WQ + (size_t)l * SZ_SQ), T, 1024, 1024, 1024, 1024, 0}; pg8::StaticOrder S; S.init(T, 1024, cx.G, cx.bid);
            pg8::EpiB<1> E{BIG, 1024, 0, 0, ssqb + (size_t)(l * 4 + 2) * T * 16, nullptr, nullptr}; pg8::gemm_phase<pg8::EpiB<1>, pg8::StaticOrder>(cx.lds, g, S, E);
        }
        if (EN(OP_XATT) && op == OP_XATT) phase_xattn(cx, p, ws);
        if (EN(OP_G1) && op == OP_G1) {
            pg8::Gemm g{XB, (const bf16_t*)(ws + OFF_GUV), T, 4096, 1024, 1024, 1024, 0}; pg8::StaticOrder S; S.init(T, 4096, cx.G, cx.bid);
            pg8::EpiB<3> E{BIG, 2048, 0, 0, ssqb + (size_t)5 * T * 16, (float*)(ws + OFF_SSQV), (bf16_t*)(ws + OFF_BIG + BIG_V)}; pg8::gemm_phase<pg8::EpiB<3>, pg8::StaticOrder>(cx.lds, g, S, E);
        }
        if (EN(OP_SPATIAL) && op == OP_SPATIAL) phase_spatial(cx, p, ws);
        if (EN(OP_FINAL) && op == OP_FINAL) phase_final(cx, p, ws);
        if (ph + 1 < p_.ph_hi) grid.sync();
    }
}

extern "C" void kernel_launch(void* const* d_in, const int* in_sizes, int n_in, void* d_out, int out_size, void* d_ws, size_t ws_size, hipStream_t stream) {
    static int grid = 0;
    if (grid == 0) {
        if (n_in != 36 || ws_size < WS_END) { fprintf(stderr, "kernel_launch: expected 36 inputs and >= %zu bytes of workspace (got %d, %zu)\n", (size_t)WS_END, n_in, ws_size); grid = -1; return; }
        int dev = 0, cus = 0, per_cu = 0;
        hipGetDevice(&dev); hipDeviceGetAttribute(&cus, hipDeviceAttributeMultiprocessorCount, dev);
        if (hipFuncSetAttribute((const void*)fwd_kernel, hipFuncAttributeMaxDynamicSharedMemorySize, LDS_BYTES) != hipSuccess) { fprintf(stderr, "kernel_launch: hipFuncSetAttribute failed\n"); grid = -1; return; }
        if (hipOccupancyMaxActiveBlocksPerMultiprocessor(&per_cu, (const void*)fwd_kernel, 512, LDS_BYTES) != hipSuccess || per_cu < 1) { fprintf(stderr, "kernel_launch: occupancy query says %d\n", per_cu); per_cu = 1; }
        (void)hipGetLastError();
        grid = cus * 1;
    }
    if (grid < 0) return;
    Params p{};
    for (int i = 0; i < 36; ++i) p.in[i] = (const float*)d_in[i];
    p.out = (float*)d_out; p.ws = (unsigned char*)d_ws;
#if MEGA
    p.ph_lo = 0; p.ph_hi = NPHASE;
    void* args[] = {&p};
    hipError_t e = hipLaunchCooperativeKernel((const void*)fwd_kernel, dim3(grid), dim3(512), args, LDS_BYTES, stream);
    if (e != hipSuccess) fprintf(stderr, "cooperative launch failed: %s (grid %d)\n", hipGetErrorString(e), grid);
#else
    for (int ph = 0; ph < NPHASE; ++ph) { p.ph_lo = ph; p.ph_hi = ph + 1; hipLaunchKernelGGL(fwd_kernel, dim3(grid), dim3(512), LDS_BYTES, stream, p); }
#endif
}
```

```cpp
#include <hip/hip_runtime.h>
#include <hip/hip_cooperative_groups.h>
#include <cstdio>
namespace cg = cooperative_groups;

#ifndef MEGA
#define MEGA 1
#endif
#ifndef PHMASK
#define PHMASK 0xFFFFF
#endif
#define EN(x) ((PHMASK >> (x)) & 1)
#ifndef REP_PH
#define REP_PH -1
#define REP_N 0
#endif

#define LAS __attribute__((address_space(3)))
typedef unsigned short bf16_t;
typedef short bf16x8 __attribute__((ext_vector_type(8)));
typedef float f32x4 __attribute__((ext_vector_type(4)));
typedef float f32x2 __attribute__((ext_vector_type(2)));
typedef unsigned u32x4 __attribute__((ext_vector_type(4)));
typedef unsigned u32x2 __attribute__((ext_vector_type(2)));

constexpr int T = 32768, C = 1024, FF = 2816, SEQ = 4096, NB = 8;
constexpr int NRK = 3072;
constexpr int NLO = 512;
constexpr int LDS_TAB = 131072;
constexpr int LDS_PF = 135168;
constexpr int LDS_BAR = 163824;
constexpr int LDS_BYTES = LDS_BAR + 16;
constexpr float RMS_EPS = 1e-6f;

constexpr size_t SZ_WIN = (size_t)5632 * 1024 * 2, SZ_WOUT = (size_t)1024 * 2816 * 2, SZ_SQ = (size_t)1024 * 1024 * 2;
constexpr size_t OFF_WIN = 0;
constexpr size_t OFF_WOUT = OFF_WIN + 4 * SZ_WIN;
constexpr size_t OFF_WQ = OFF_WOUT + 4 * SZ_WOUT;
constexpr size_t OFF_WO = OFF_WQ + 2 * SZ_SQ;
constexpr size_t OFF_WMK = OFF_WO + 2 * SZ_SQ;
constexpr size_t OFF_WMV = OFF_WMK + SZ_SQ;
constexpr size_t OFF_WRK = OFF_WMV + SZ_SQ;
constexpr size_t OFF_WLO = OFF_WRK + (size_t)NRK * 1024 * 2;
constexpr size_t OFF_W2T = OFF_WRK + (size_t)3584 * 2048 * 2;
constexpr size_t OFF_A2T = OFF_W2T + 1024 * 64 * 2;
constexpr size_t OFF_G2T = OFF_A2T + 1024 * 64 * 2;
constexpr size_t OFF_RWO = OFF_G2T + 1024 * 160 * 2;
constexpr size_t OFF_GUV = OFF_RWO + SZ_SQ;
constexpr size_t OFF_GWO = OFF_GUV + (size_t)4096 * 1024 * 2;
constexpr size_t OFF_WS16 = OFF_GWO + (size_t)1024 * 2048 * 2;
constexpr size_t OFF_SSQ = OFF_WS16 + 16 * 128 * 128 * 2;
constexpr size_t OFF_SSQV = OFF_SSQ + (size_t)9 * T * 4 * 4;
constexpr size_t OFF_BONUS = OFF_SSQV + (size_t)T * 32 * 4;
constexpr size_t OFF_GNST = OFF_BONUS + (size_t)T * 16 * 4;
constexpr size_t OFF_MEMN = OFF_GNST + (size_t)T * 16 * 2 * 8;
constexpr size_t OFF_MK = OFF_MEMN + (size_t)2048 * 1024 * 2;
constexpr size_t OFF_VT = OFF_MK + (size_t)2048 * 1024 * 2;
constexpr size_t OFF_XB = OFF_VT + (size_t)2048 * 1024 * 2;
constexpr size_t OFF_BIG = OFF_XB + (size_t)(NB * 4097) * 1024 * 2 + 4096;
constexpr size_t BIG_L = (size_t)T * NRK * 2;
constexpr size_t BIG_Y = (size_t)T * 3584 * 2;
constexpr size_t BIG_V = (size_t)T * 2048 * 2;
constexpr size_t BIG_O = (size_t)T * 1024 * 2;
constexpr size_t BIG_P = 2 * BIG_O;
constexpr size_t OFF_BAR = OFF_BIG + BIG_Y + (size_t)T * 1024 * 2 + 32768;
constexpr size_t WS_END = OFF_BAR + 16384;
static_assert(WS_END <= (size_t)536870912, "workspace");

struct Params { const float* in[36]; float* out; unsigned char* ws; int ph_lo, ph_hi; };
typedef const __attribute__((address_space(4))) Params* PP;

__device__ __forceinline__ unsigned cvt_pk_bf16(float lo, float hi) { unsigned r; asm("v_cvt_pk_bf16_f32 %0, %1, %2" : "=v"(r) : "v"(lo), "v"(hi)); return r; }
__device__ __forceinline__ float bf_lo(unsigned w) { return __uint_as_float(w << 16); }
__device__ __forceinline__ float bf_hi(unsigned w) { return __uint_as_float(w & 0xffff0000u); }
template <int CTRL> __device__ __forceinline__ float dppf(float x) { return __int_as_float(__builtin_amdgcn_update_dpp(__float_as_int(x), __float_as_int(x), CTRL, 0xf, 0xf, false)); }
__device__ __forceinline__ float allred8(float x) { x += dppf<0xB1>(x); x += dppf<0x4E>(x); x += dppf<0x141>(x); return x; }
__device__ __forceinline__ float allred16(float x) { x = allred8(x); x += dppf<0x140>(x); return x; }
__device__ __forceinline__ void fred16x4(float& a, float& b, float& c, float& d) {
#define DPP4(ctrl) "v_add_f32_dpp %0, %0, %0 " ctrl " row_mask:0xf bank_mask:0xf\n\tv_add_f32_dpp %1, %1, %1 " ctrl " row_mask:0xf bank_mask:0xf\n\tv_add_f32_dpp %2, %2, %2 " ctrl " row_mask:0xf bank_mask:0xf\n\tv_add_f32_dpp %3, %3, %3 " ctrl " row_mask:0xf bank_mask:0xf\n\t"
    asm("s_nop 1\n\t" DPP4("quad_perm:[1,0,3,2]") DPP4("quad_perm:[2,3,0,1]") DPP4("row_half_mirror") DPP4("row_mirror") : "+v"(a), "+v"(b), "+v"(c), "+v"(d));
#undef DPP4
}
__device__ __forceinline__ void fred16x2(float& a, float& b) {
#define DPP2(ctrl) "v_add_f32_dpp %0, %0, %0 " ctrl " row_mask:0xf bank_mask:0xf\n\tv_add_f32_dpp %1, %1, %1 " ctrl " row_mask:0xf bank_mask:0xf\n\t"
    asm("s_nop 1\n\t" DPP2("quad_perm:[1,0,3,2]") "s_nop 0\n\t" DPP2("quad_perm:[2,3,0,1]") "s_nop 0\n\t" DPP2("row_half_mirror") "s_nop 0\n\t" DPP2("row_mirror") : "+v"(a), "+v"(b));
#undef DPP2
}
__device__ __forceinline__ float treduce16(const float (&P)[16], int lane) {
    const bool h = lane & 8, g = lane & 4, f = lane & 2, e = lane & 1;
    float k1[8], s1[8], a[8];
#pragma unroll
    for (int j = 0; j < 8; ++j) { k1[j] = h ? P[8 + j] : P[j]; s1[j] = h ? P[j] : P[8 + j]; }
    asm("s_nop 1\n\tv_add_f32_dpp %0, %8, %16 row_mirror row_mask:0xf bank_mask:0xf\n\tv_add_f32_dpp %1, %9, %17 row_mirror row_mask:0xf bank_mask:0xf\n\tv_add_f32_dpp %2, %10, %18 row_mirror row_mask:0xf bank_mask:0xf\n\t"
        "v_add_f32_dpp %3, %11, %19 row_mirror row_mask:0xf bank_mask:0xf\n\tv_add_f32_dpp %4, %12, %20 row_mirror row_mask:0xf bank_mask:0xf\n\tv_add_f32_dpp %5, %13, %21 row_mirror row_mask:0xf bank_mask:0xf\n\t"
        "v_add_f32_dpp %6, %14, %22 row_mirror row_mask:0xf bank_mask:0xf\n\tv_add_f32_dpp %7, %15, %23 row_mirror row_mask:0xf bank_mask:0xf"
        : "=&v"(a[0]), "=&v"(a[1]), "=&v"(a[2]), "=&v"(a[3]), "=&v"(a[4]), "=&v"(a[5]), "=&v"(a[6]), "=&v"(a[7])
        : "v"(s1[0]), "v"(s1[1]), "v"(s1[2]), "v"(s1[3]), "v"(s1[4]), "v"(s1[5]), "v"(s1[6]), "v"(s1[7]), "v"(k1[0]), "v"(k1[1]), "v"(k1[2]), "v"(k1[3]), "v"(k1[4]), "v"(k1[5]), "v"(k1[6]), "v"(k1[7]));
    float k2[4], s2[4], b[4];
#pragma unroll
    for (int j = 0; j < 4; ++j) { k2[j] = g ? a[4 + j] : a[j]; s2[j] = g ? a[j] : a[4 + j]; }
    asm("s_nop 1\n\tv_add_f32_dpp %0, %4, %8 row_half_mirror row_mask:0xf bank_mask:0xf\n\tv_add_f32_dpp %1, %5, %9 row_half_mirror row_mask:0xf bank_mask:0xf\n\t"
        "v_add_f32_dpp %2, %6, %10 row_half_mirror row_mask:0xf bank_mask:0xf\n\tv_add_f32_dpp %3, %7, %11 row_half_mirror row_mask:0xf bank_mask:0xf"
        : "=&v"(b[0]), "=&v"(b[1]), "=&v"(b[2]), "=&v"(b[3]) : "v"(s2[0]), "v"(s2[1]), "v"(s2[2]), "v"(s2[3]), "v"(k2[0]), "v"(k2[1]), "v"(k2[2]), "v"(k2[3]));
    float k3[2], s3[2], c[2];
#pragma unroll
    for (int j = 0; j < 2; ++j) { k3[j] = f ? b[2 + j] : b[j]; s3[j] = f ? b[j] : b[2 + j]; }
    asm("s_nop 1\n\tv_add_f32_dpp %0, %2, %4 quad_perm:[3,2,1,0] row_mask:0xf bank_mask:0xf\n\tv_add_f32_dpp %1, %3, %5 quad_perm:[3,2,1,0] row_mask:0xf bank_mask:0xf"
        : "=&v"(c[0]), "=&v"(c[1]) : "v"(s3[0]), "v"(s3[1]), "v"(k3[0]), "v"(k3[1]));
    const float k4 = e ? c[1] : c[0], s4 = e ? c[0] : c[1]; float r;
    asm("s_nop 1\n\tv_add_f32_dpp %0, %1, %2 quad_perm:[1,0,3,2] row_mask:0xf bank_mask:0xf" : "=&v"(r) : "v"(s4), "v"(k4));
    return r;
}
__device__ __forceinline__ float fred16(float x) {
    asm("s_nop 1\n\tv_add_f32_dpp %0, %0, %0 quad_perm:[1,0,3,2] row_mask:0xf bank_mask:0xf\n\ts_nop 1\n\tv_add_f32_dpp %0, %0, %0 quad_perm:[2,3,0,1] row_mask:0xf bank_mask:0xf\n\t"
        "s_nop 1\n\tv_add_f32_dpp %0, %0, %0 row_half_mirror row_mask:0xf bank_mask:0xf\n\ts_nop 1\n\tv_add_f32_dpp %0, %0, %0 row_mirror row_mask:0xf bank_mask:0xf" : "+v"(x));
    return x; }
__device__ __forceinline__ float sigmoidf_(float x) { return __builtin_amdgcn_rcpf(1.0f + __expf(-x)); }
__device__ __forceinline__ float tanhf_(float x) { const float e = __expf(-2.0f * fabsf(x)); const float t = (1.0f - e) * __builtin_amdgcn_rcpf(1.0f + e); return x < 0.f ? -t : t; }
__device__ __forceinline__ float gelu_tanh(float x) { const float t = x * (-2.3022081981f - 0.1029432398f * (x * x)); return x * __builtin_amdgcn_rcpf(1.0f + __builtin_amdgcn_exp2f(t)); }
__device__ __forceinline__ float ssq4(const float* part) { const f32x4 a = *(const f32x4*)part; return (a[0] + a[1]) + (a[2] + a[3]); }
__device__ __forceinline__ float ssq16(const float* part) { const f32x4 a = *(const f32x4*)part, b = *(const f32x4*)(part + 4), c = *(const f32x4*)(part + 8), d = *(const f32x4*)(part + 12);
    return (((a[0] + a[1]) + (a[2] + a[3])) + ((b[0] + b[1]) + (b[2] + b[3]))) + (((c[0] + c[1]) + (c[2] + c[3])) + ((d[0] + d[1]) + (d[2] + d[3]))); }
#define LBAR() do { asm volatile("s_waitcnt lgkmcnt(0)" ::: "memory"); __builtin_amdgcn_s_barrier(); asm volatile("" ::: "memory"); } while (0)

namespace pg8 {
constexpr int BM = 256, BK = 64, HALF = 128, HTB = HALF * BK * 2, NXCD = 8, WGM = 8;
__host__ __device__ __forceinline__ int lds_byte(int r, int c) { const int st = (r >> 4) * 2 + (c >> 5), rr = r & 15, cc = c & 31, ob = rr * 64 + cc * 2; return st * 1024 + (ob ^ (((ob >> 9) & 1) << 5)); }
__host__ __device__ __forceinline__ void stage_rc(int b, int& R, int& Cc) { const int st = b / 1024, sb = b % 1024, swz = sb ^ (((sb >> 9) & 1) << 5); R = (st >> 1) * 16 + swz / 64; Cc = (st & 1) * 32 + (swz % 64) / 2; }
__host__ __device__ __forceinline__ int perm32(int rho) { const int n = rho >> 4, i = rho & 15; return 8 * (i >> 2) + 4 * n + (i & 3); }

struct Unit { int pm, pn; };
struct Gemm { const bf16_t* A; const bf16_t* Bt; int M, N, K, lda, ldb; size_t padA; const bf16_t* A1; const bf16_t* A2; };

struct StaticOrder {
    int nM, nN, nwg, G, c;
    __device__ void init(int M, int N, int G_, int c_) { nM = M / BM; nN = N / BM; nwg = nM * nN; G = G_; c = c_; }
    __device__ bool next(int i, Unit& u) const {
        const long L = (long)i * G + c; if (L >= nwg) return false;
        int wgid = (int)L; { const int q = nwg / NXCD, r = nwg % NXCD, xcd = wgid % NXCD, off = wgid / NXCD; wgid = (xcd < r ? xcd * (q + 1) : r * (q + 1) + (xcd - r) * q) + off; }
        const int nig = WGM * nN, gid = wgid / nig, fm = gid * WGM, gsz = (nM - fm) < WGM ? (nM - fm) : WGM;
        u.pm = fm + ((wgid % nig) % gsz); u.pn = (wgid % nig) / gsz; return true;
    }
};
struct SingleUnit { __device__ bool next(int i, Unit& u) const { u.pm = 0; u.pn = 0; return i == 0; } };

template <class Epi, class Sched>
__device__ __forceinline__ void gemm_phase(LAS unsigned char* lds, const Gemm g, const Sched& S, const Epi& E) {
    int tid_ = threadIdx.x; asm volatile("" : "+v"(tid_));
    const int tid = tid_, wid = __builtin_amdgcn_readfirstlane(tid >> 6), lane = tid & 63, wr = wid >> 2, wc = wid & 3, fr = lane & 15, fq = lane >> 4;
    const int K = g.K, nt = K / BK;
    unsigned voffA[2], voffB[2];
#pragma unroll
    for (int i = 0; i < 2; ++i) { int R, Cc; stage_rc(tid * 16 + i * 8192, R, Cc); const int Rb = Epi::PERM ? ((R & ~31) + perm32(R & 31)) : R;
        voffA[i] = (unsigned)(R * g.lda + Cc) * 2u; voffB[i] = (unsigned)(Rb * g.ldb + Cc) * 2u; }
    const size_t kstep = (size_t)(BK * 2);
    const size_t hstepA = (size_t)HALF * g.lda * 2, hstepB = (size_t)HALF * g.ldb * 2;
    const size_t tstepA = 2 * hstepA, tstepB = 2 * hstepB;
    const unsigned ldsw = (unsigned)wid * 1024u;
    const int aoff = lds_byte(wr * 64 + fr, fq * 8), boff = lds_byte(wc * 32 + fr, fq * 8);
#define PG8_SA(b, h) (((b) * 2 + (h)) * HTB)
#define PG8_SB(b, h) ((4 + (b) * 2 + (h)) * HTB)
#define PG8_STAGE(bufoff, gbase, voff) do { _Pragma("unroll") for (int _i = 0; _i < 2; ++_i) \
        __builtin_amdgcn_global_load_lds((const unsigned*)((const char*)(gbase) + (voff)[_i]), (LAS unsigned*)(lds + (bufoff) + ldsw + _i * 8192), 16, 0, 0); } while (0)
#define PG8_LDA(dst, b, h) do { _Pragma("unroll") for (int m = 0; m < 4; ++m) _Pragma("unroll") for (int k = 0; k < 2; ++k) dst[m][k] = *(const LAS bf16x8*)(lds + PG8_SA(b, h) + aoff + m * 2048 + k * 1024); } while (0)
#define PG8_LDB(dst, b, h) do { _Pragma("unroll") for (int n = 0; n < 2; ++n) _Pragma("unroll") for (int k = 0; k < 2; ++k) dst[n][k] = *(const LAS bf16x8*)(lds + PG8_SB(b, h) + boff + n * 2048 + k * 1024); } while (0)
#define PG8_MMA(ai, bj, At, Bt) do { __builtin_amdgcn_s_setprio(1); _Pragma("unroll") for (int m = 0; m < 4; ++m) _Pragma("unroll") for (int n = 0; n < 2; ++n) _Pragma("unroll") for (int k = 0; k < 2; ++k) \
        acc[ai][bj][m][n] = __builtin_amdgcn_mfma_f32_16x16x32_bf16(Bt[n][k], At[m][k], acc[ai][bj][m][n], 0, 0, 0); __builtin_amdgcn_s_setprio(0); } while (0)
#define PG8_WAIT_V(n) asm volatile("s_waitcnt vmcnt(" #n ")" ::: "memory")
#define PG8_WAIT_L(n) asm volatile("s_waitcnt lgkmcnt(" #n ")" ::: "memory")
#define PG8_BAR __builtin_amdgcn_s_barrier()
#define PG8_SCHED __builtin_amdgcn_sched_barrier(0)
#define PG8_APTR(u) ((const char*)((g.A1 && (u).pn >= 4) ? ((u).pn >= 8 ? g.A2 : g.A1) : g.A) + (size_t)(u).pm * tstepA + (size_t)((u).pm >> 4) * g.padA)
#define PG8_BPTR(u) ((const char*)g.Bt + (size_t)(u).pn * tstepB)
    Unit cur, nxt; int ui = 0;
    if (!S.next(0, cur)) return;
    f32x4 acc[2][2][4][2];
#pragma unroll
    for (int a = 0; a < 2; ++a)
#pragma unroll
        for (int b = 0; b < 2; ++b)
#pragma unroll
            for (int m = 0; m < 4; ++m)
#pragma unroll
                for (int n = 0; n < 2; ++n) acc[a][b][m][n] = (f32x4){0.f, 0.f, 0.f, 0.f};
    bf16x8 At[4][2], B0[2][2], B1[2][2];
    const char* cA = PG8_APTR(cur); const char* cB = PG8_BPTR(cur);
    PG8_STAGE(PG8_SB(0, 0), cB, voffB); PG8_STAGE(PG8_SA(0, 0), cA, voffA); PG8_STAGE(PG8_SB(0, 1), cB + hstepB, voffB); PG8_STAGE(PG8_SA(0, 1), cA + hstepA, voffA);
    if (wr == 1) PG8_BAR;
    PG8_WAIT_V(4); PG8_BAR;
    PG8_STAGE(PG8_SB(1, 0), cB + kstep, voffB); PG8_STAGE(PG8_SA(1, 0), cA + kstep, voffA); PG8_STAGE(PG8_SB(1, 1), cB + hstepB + kstep, voffB);
    PG8_WAIT_V(6); PG8_BAR;
    for (;;) {
        if constexpr (Epi::PREFETCH) E.prefetch(cur, wr, fr, fq, lds, wid);
        const bool has_next = S.next(ui + 1, nxt);
        const char* nA = has_next ? PG8_APTR(nxt) : cA; const char* nB = has_next ? PG8_BPTR(nxt) : cB;
        for (int t = 0; t < nt; t += 2) {
            const bool last = (t == nt - 2);
            const char* a1 = cA + (size_t)(t + 1) * kstep;
            const char* a2 = last ? nA : cA + (size_t)(t + 2) * kstep; const char* b2 = last ? nB : cB + (size_t)(t + 2) * kstep;
            const char* a3 = a2 + kstep; const char* b3 = b2 + kstep;
            PG8_LDB(B0, 0, 0); PG8_SCHED; PG8_LDA(At, 0, 0); PG8_STAGE(PG8_SA(1, 1), a1 + hstepA, voffA);
            PG8_WAIT_L(8); PG8_BAR; PG8_WAIT_L(0); PG8_MMA(0, 0, At, B0); PG8_BAR; PG8_SCHED;
            PG8_LDB(B1, 0, 1); PG8_STAGE(PG8_SB(0, 0), b2, voffB);
            PG8_BAR; PG8_WAIT_L(0); PG8_MMA(0, 1, At, B1); PG8_BAR;
            PG8_LDA(At, 0, 1); PG8_STAGE(PG8_SA(0, 0), a2, voffA);
            PG8_BAR; PG8_WAIT_L(0); PG8_MMA(1, 0, At, B0); PG8_BAR; PG8_SCHED;
            PG8_STAGE(PG8_SB(0, 1), b2 + hstepB, voffB);
            PG8_WAIT_V(6); PG8_BAR; PG8_MMA(1, 1, At, B1); PG8_BAR;
            PG8_LDB(B0, 1, 0); PG8_SCHED; PG8_LDA(At, 1, 0); PG8_STAGE(PG8_SA(0, 1), a2 + hstepA, voffA);
            PG8_WAIT_L(8); PG8_BAR; PG8_WAIT_L(0); PG8_MMA(0, 0, At, B0); PG8_BAR; PG8_SCHED;
            PG8_LDB(B1, 1, 1); PG8_STAGE(PG8_SB(1, 0), b3, voffB);
            PG8_BAR; PG8_WAIT_L(0); PG8_MMA(0, 1, At, B1); PG8_BAR;
            PG8_LDA(At, 1, 1); PG8_STAGE(PG8_SA(1, 0), a3, voffA);
            PG8_BAR; PG8_WAIT_L(0); PG8_MMA(1, 0, At, B0); PG8_BAR; PG8_SCHED;
            PG8_STAGE(PG8_SB(1, 1), b3 + hstepB, voffB);
            PG8_WAIT_V(6); PG8_BAR; PG8_MMA(1, 1, At, B1); PG8_BAR;
        }
        if constexpr (!Epi::AFTER_DRAIN) { E(acc, cur, wr, wc, fr, fq, lds, wid); }
        if (!has_next) break;
#pragma unroll
        for (int a = 0; a < 2; ++a)
#pragma unroll
            for (int b = 0; b < 2; ++b)
#pragma unroll
                for (int m = 0; m < 4; ++m)
#pragma unroll
                    for (int n = 0; n < 2; ++n) acc[a][b][m][n] = (f32x4){0.f, 0.f, 0.f, 0.f};
        cur = nxt; cA = nA; cB = nB; ++ui;
    }
    PG8_WAIT_V(0);
    if (wr == 0) PG8_BAR;
    PG8_BAR;
    if constexpr (Epi::AFTER_DRAIN) { E.fused(acc, cur, wr, wc, fr, fq, lds, wid, lane); }
#undef PG8_SA
#undef PG8_SB
#undef PG8_STAGE
#undef PG8_LDA
#undef PG8_LDB
#undef PG8_MMA
#undef PG8_WAIT_V
#undef PG8_WAIT_L
#undef PG8_BAR
#undef PG8_SCHED
#undef PG8_APTR
#undef PG8_BPTR
}

typedef f32x4 AccT[2][2][4][2];
__device__ __forceinline__ void lane_pf8(const float* ssq, int row0, int fq, LAS unsigned char* lds, int wid) {
    const float* bp = ssq + (size_t)row0 * 4 + fq; asm volatile("" : "+v"(bp));
#pragma unroll
    for (int g8 = 0; g8 < 8; ++g8) __builtin_amdgcn_global_load_lds((const unsigned*)(bp + ((g8 >> 2) * HALF + (g8 & 3) * 16) * 4), (LAS unsigned*)(lds + LDS_PF + wid * 2048 + g8 * 256), 4, 0, 0);
}
__device__ __forceinline__ void lane_rstd8(LAS unsigned char* lds, int wid, int lane, float invn, float (&rs)[8]) {
#pragma unroll
    for (int g8 = 0; g8 < 8; ++g8) { float t = *(const LAS float*)(lds + LDS_PF + wid * 2048 + g8 * 256 + lane * 4); t += __shfl_xor(t, 16); t += __shfl_xor(t, 32); rs[g8] = rsqrtf(t * invn + RMS_EPS); }
}
struct EpiSwiGLU {
    static constexpr bool PERM = true, AFTER_DRAIN = false, PREFETCH = true;
    bf16_t* H; const float* ssq;
    __device__ __forceinline__ void prefetch(const Unit& u, int wr, int fr, int fq, LAS unsigned char* lds, int wid) const { lane_pf8(ssq, u.pm * BM + wr * 64 + fr, fq, lds, wid); }
    __device__ __forceinline__ void operator()(const AccT& acc, const Unit& u, int wr, int wc, int fr, int fq, LAS unsigned char* lds_, int wid_) const {
        const int row0 = u.pm * BM + wr * 64 + fr, col0 = u.pn * 128 + wc * 32 + 8 * fq;
        float rs8[8]; lane_rstd8(lds_, wid_, fr + 16 * fq, 1.0f / 1024.0f, rs8);
#pragma unroll
        for (int ai = 0; ai < 2; ++ai)
#pragma unroll
            for (int m = 0; m < 4; ++m) { const int row = row0 + ai * HALF + m * 16; const float rs = rs8[ai * 4 + m]; const float rs2 = rs * rs, nrl = -1.4426950409f * rs;
                f32x4 h4[2];
#pragma unroll
                for (int n = 0; n < 2; ++n) { const f32x4 g4 = acc[ai][0][m][n], u4 = acc[ai][1][m][n]; const f32x4 t4 = g4 * nrl; f32x4 e4, r4;
#pragma unroll
                    for (int e = 0; e < 4; ++e) e4[e] = __builtin_amdgcn_exp2f(t4[e]);
                    const f32x4 d4 = e4 + 1.0f;
#pragma unroll
                    for (int e = 0; e < 4; ++e) r4[e] = __builtin_amdgcn_rcpf(d4[e]);
                    h4[n] = (g4 * u4) * (r4 * rs2); }
                u32x4 w; w.x = cvt_pk_bf16(h4[0][0], h4[0][1]); w.y = cvt_pk_bf16(h4[0][2], h4[0][3]); w.z = cvt_pk_bf16(h4[1][0], h4[1][1]); w.w = cvt_pk_bf16(h4[1][2], h4[1][3]);
                __builtin_nontemporal_store(w, (u32x4*)(H + (size_t)row * FF + col0)); asm volatile("" ::: "memory"); }
    }
};
struct EpiResid {
    static constexpr bool PERM = true, AFTER_DRAIN = false, PREFETCH = false;
    bf16_t* xb; float* ssq; float alpha; LAS unsigned char* lds;
    __device__ __forceinline__ void prefetch(const Unit&, int, int, int, LAS unsigned char*, int) const {}
    __device__ __forceinline__ void operator()(const AccT& acc, const Unit& u, int wr, int wc, int fr, int fq, LAS unsigned char*, int) const {
        LAS float* tab = (LAS float*)(lds + LDS_TAB);
        const int row0 = u.pm * BM + wr * 64 + fr, col0 = u.pn * BM + wc * 32 + 8 * fq;
        u32x4 xv[2][2];
#define RES_LOAD(g8, buf) do { const size_t off_ = (size_t)(row0 + ((g8) >> 2) * HALF + ((g8) & 3) * 16) * C + col0; \
            buf[0] = *(const u32x4*)(xb + off_); buf[1] = *(const u32x4*)(xb + off_ + HALF); } while (0)
        RES_LOAD(0, xv[0]);
#pragma unroll
        for (int g8 = 0; g8 < 8; ++g8) { const int ai = g8 >> 2, m = g8 & 3;
            if (g8 + 1 < 8) RES_LOAD(g8 + 1, xv[(g8 + 1) & 1]);
            const int row = row0 + ai * HALF + m * 16; const size_t off = (size_t)row * C + col0; float s = 0.f;
#pragma unroll
            for (int bj = 0; bj < 2; ++bj) { const u32x4 xw = xv[g8 & 1][bj];
                const f32x4 r0 = (f32x4){bf_lo(xw.x), bf_hi(xw.x), bf_lo(xw.y), bf_hi(xw.y)} + alpha * acc[ai][bj][m][0];
                const f32x4 r1 = (f32x4){bf_lo(xw.z), bf_hi(xw.z), bf_lo(xw.w), bf_hi(xw.w)} + alpha * acc[ai][bj][m][1];
                u32x4 w; w.x = cvt_pk_bf16(r0[0], r0[1]); w.y = cvt_pk_bf16(r0[2], r0[3]); w.z = cvt_pk_bf16(r1[0], r1[1]); w.w = cvt_pk_bf16(r1[2], r1[3]);
                __builtin_nontemporal_store(w, (u32x4*)(xb + off + bj * HALF));
                s += ((r0[0] * r0[0] + r0[1] * r0[1]) + (r0[2] * r0[2] + r0[3] * r0[3])) + ((r1[0] * r1[0] + r1[1] * r1[1]) + (r1[2] * r1[2] + r1[3] * r1[3])); }
            s += __shfl_xor(s, 16); s += __shfl_xor(s, 32);
            if (fq == 0) tab[(ai * HALF + wr * 64 + m * 16 + fr) * 4 + wc] = s; asm volatile("" ::: "memory"); }
#undef RES_LOAD
        asm volatile("s_waitcnt lgkmcnt(0)" ::: "memory"); __builtin_amdgcn_s_barrier(); __builtin_amdgcn_s_barrier(); asm volatile("" ::: "memory");
        if (wr == 0) { const int r = wc * 64 + fq * 16 + fr; const f32x4 t = *(const LAS f32x4*)(tab + r * 4); ssq[(size_t)(u.pm * BM + r) * 4 + u.pn] = (t[0] + t[1]) + (t[2] + t[3]); }
    }
};
template <int MODE> struct EpiB {
    static constexpr bool PERM = true, AFTER_DRAIN = false, PREFETCH = (MODE == 1 || MODE == 3);
    bf16_t* O; int ldc; int row_base, col_base; const float* ssq; float* ssqv; bf16_t* O2;
    __device__ __forceinline__ void prefetch(const Unit& u, int wr, int fr, int fq, LAS unsigned char* lds, int wid) const { if (MODE == 1 || MODE == 3) lane_pf8(ssq, u.pm * BM + wr * 64 + fr, fq, lds, wid); }
    __device__ __forceinline__ void operator()(const AccT& acc, const Unit& u, int wr, int wc, int fr, int fq, LAS unsigned char* lds_, int wid_) const {
        const int row0 = u.pm * BM + wr * 64 + fr; const int colt = u.pn * BM + wc * 32 + 8 * fq;
        float rs8[8];
        if (MODE == 1 || MODE == 3) lane_rstd8(lds_, wid_, fr + 16 * fq, 1.0f / 1024.0f, rs8);
#pragma unroll
        for (int ai = 0; ai < 2; ++ai)
#pragma unroll
            for (int m = 0; m < 4; ++m) { const int row = row0 + ai * HALF + m * 16; float rs = 1.0f; float sq = 0.f;
                if (MODE == 1 || MODE == 3) rs = rs8[ai * 4 + m];
#pragma unroll
                for (int bj = 0; bj < 2; ++bj) { const int col = colt + bj * HALF; f32x4 v4[2];
#pragma unroll
                    for (int n = 0; n < 2; ++n) { f32x4 x4 = acc[ai][bj][m][n]; if (MODE == 1 || MODE == 3) x4 = x4 * rs;
                        if (MODE == 2) { if (col < 64) {
#pragma unroll
                                for (int e = 0; e < 4; ++e) x4[e] = tanhf_(x4[e]); }
                            else if (col >= 128 && col < 288) {
#pragma unroll
                                for (int e = 0; e < 4; ++e) x4[e] = sigmoidf_(x4[e]); } }
                        if (MODE == 3) {
                            const f32x4 t4 = x4 * ((x4 * x4) * (-0.1029432398f) + (-2.3022081981f)); f32x4 e4, r4;
#pragma unroll
                            for (int e = 0; e < 4; ++e) e4[e] = __builtin_amdgcn_exp2f(t4[e]);
                            const f32x4 d4 = e4 + 1.0f;
#pragma unroll
                            for (int e = 0; e < 4; ++e) r4[e] = __builtin_amdgcn_rcpf(d4[e]);
                            x4 = x4 * r4; if (u.pn >= 8) { const f32x4 q4 = x4 * x4; sq += (q4[0] + q4[1]) + (q4[2] + q4[3]); } }
                        v4[n] = x4; }
                    u32x4 w; w.x = cvt_pk_bf16(v4[0][0], v4[0][1]); w.y = cvt_pk_bf16(v4[0][2], v4[0][3]); w.z = cvt_pk_bf16(v4[1][0], v4[1][1]); w.w = cvt_pk_bf16(v4[1][2], v4[1][3]);
                    if (MODE == 3) { bf16_t* dst = (col < 2048) ? (O + (size_t)row * 2048 + col) : (O2 + (size_t)row * 2048 + (col - 2048)); __builtin_nontemporal_store(w, (u32x4*)dst); }
                    else __builtin_nontemporal_store(w, (u32x4*)(O + (size_t)(row_base + row) * ldc + col_base + col)); }
                if (MODE == 3) { if (u.pn >= 8) { sq += __shfl_xor(sq, 16); sq += __shfl_xor(sq, 32); if (fq == 0) ssqv[(size_t)row * 32 + (u.pn - 8) * 4 + wc] = sq; } } asm volatile("" ::: "memory"); }
    }
};
struct EpiSoftmax {
    static constexpr bool PERM = true, AFTER_DRAIN = true, PREFETCH = false;
    bf16_t* P;
    __device__ __forceinline__ void prefetch(const Unit&, int, int, int, LAS unsigned char*, int) const {}
    __device__ __forceinline__ void fused(AccT& acc, const Unit& u, int wr, int wc, int fr, int fq, LAS unsigned char* lds, int wid, int lane) const {
        LAS float* tab = (LAS float*)lds;
#pragma unroll
        for (int ai = 0; ai < 2; ++ai)
#pragma unroll
            for (int m = 0; m < 4; ++m) { float mx = -3.0e38f;
#pragma unroll
                for (int bj = 0; bj < 2; ++bj)
#pragma unroll
                    for (int n = 0; n < 2; ++n)
#pragma unroll
                        for (int e = 0; e < 4; ++e) mx = fmaxf(mx, acc[ai][bj][m][n][e]);
                mx = fmaxf(mx, __shfl_xor(mx, 16)); mx = fmaxf(mx, __shfl_xor(mx, 32));
                if (fq == 0) tab[(ai * HALF + wr * 64 + m * 16 + fr) * 4 + wc] = mx; }
        LBAR();
        float sums[2][4];
#pragma unroll
        for (int ai = 0; ai < 2; ++ai)
#pragma unroll
            for (int m = 0; m < 4; ++m) { const f32x4 t4 = *(const LAS f32x4*)(tab + (ai * HALF + wr * 64 + m * 16 + fr) * 4);
                const float mx = fmaxf(fmaxf(t4[0], t4[1]), fmaxf(t4[2], t4[3])); float s = 0.f;
#pragma unroll
                for (int bj = 0; bj < 2; ++bj)
#pragma unroll
                    for (int n = 0; n < 2; ++n)
#pragma unroll
                        for (int e = 0; e < 4; ++e) { const float pv = __expf(acc[ai][bj][m][n][e] - mx); acc[ai][bj][m][n][e] = pv; s += pv; }
                s += __shfl_xor(s, 16); s += __shfl_xor(s, 32); sums[ai][m] = s; asm volatile("" ::: "memory"); }
        LBAR();
#pragma unroll
        for (int ai = 0; ai < 2; ++ai)
#pragma unroll
            for (int m = 0; m < 4; ++m) if (fq == 0) tab[(ai * HALF + wr * 64 + m * 16 + fr) * 4 + wc] = sums[ai][m];
        LBAR();
#pragma unroll
        for (int ai = 0; ai < 2; ++ai)
#pragma unroll
            for (int m = 0; m < 4; ++m) { const int r = ai * HALF + wr * 64 + m * 16 + fr; const f32x4 t4 = *(const LAS f32x4*)(tab + r * 4);
                const float inv = 1.0f / ((t4[0] + t4[1]) + (t4[2] + t4[3]));
#pragma unroll
                for (int bj = 0; bj < 2; ++bj) { const f32x4 a = acc[ai][bj][m][0] * inv, b = acc[ai][bj][m][1] * inv;
                    u32x4 w; w.x = cvt_pk_bf16(a[0], a[1]); w.y = cvt_pk_bf16(a[2], a[3]); w.z = cvt_pk_bf16(b[0], b[1]); w.w = cvt_pk_bf16(b[2], b[3]);
                    *(u32x4*)(P + (size_t)r * 256 + bj * HALF + wc * 32 + 8 * fq) = w; } asm volatile("" ::: "memory"); }
        LBAR();
    }
};
}

struct Ctx { int tid, lane, wv, G, bid; LAS unsigned char* lds; };

struct TJob { const float* src; int lds_, K, N, c0; bf16_t* dst; int ldd, rowmap, drow0, dcol0; const float* g; const float* mu; int mode; float cs; };
__device__ __forceinline__ void run_tconv(const Ctx& cx, const TJob& j) {
    LAS float* tile0 = (LAS float*)cx.lds;
    const int tk = (j.K + 63) >> 6, tn = (j.N + 63) >> 6, ntile = tk * tn;
    const int kr = cx.tid >> 3, nc = (cx.tid & 7) * 8;
    f32x4 la, lb; float sc = 0.f;
#define TC_LOAD(t_) do { const int k_ = ((t_) % tk) * 64 + kr, n_ = ((t_) / tk) * 64 + nc; la = (f32x4){0.f, 0.f, 0.f, 0.f}; lb = la; sc = 0.f; \
        if (k_ < j.K && n_ < j.N) { const float* sp_ = j.src + (size_t)k_ * j.lds_ + j.c0 + n_; la = *(const f32x4*)sp_; lb = *(const f32x4*)(sp_ + 4); \
            sc = j.cs; if (j.g) sc *= j.g[k_]; if (j.mode == 1) sc *= j.mu[k_]; else if (j.mode == 2) sc *= (1.0f - j.mu[k_]); } } while (0)
    int t = cx.bid, it = 0;
    if (t < ntile) TC_LOAD(t);
    for (; t < ntile; t += cx.G, ++it) {
        LAS float* tile = tile0 + (it & 1) * (64 * 65);
        const int k0 = (t % tk) * 64, n0 = (t / tk) * 64;
        { const f32x4 a = la * sc, b = lb * sc;
#pragma unroll
            for (int e = 0; e < 4; ++e) { tile[kr * 65 + nc + e] = a[e]; tile[kr * 65 + nc + 4 + e] = b[e]; } }
        if (t + cx.G < ntile) TC_LOAD(t + cx.G);
        __syncthreads();
        { const int nr = cx.tid >> 3, kc = (cx.tid & 7) * 8; const int n = n0 + nr, k = k0 + kc;
            if (n < j.N && k < j.K) { float v[8];
#pragma unroll
                for (int e = 0; e < 8; ++e) v[e] = tile[(kc + e) * 65 + nr];
                const int drow = j.drow0 + (j.rowmap ? ((n >> 7) * 256 + (n & 127)) : n);
                u32x4 w; w.x = cvt_pk_bf16(v[0], v[1]); w.y = cvt_pk_bf16(v[2], v[3]); w.z = cvt_pk_bf16(v[4], v[5]); w.w = cvt_pk_bf16(v[6], v[7]);
                __builtin_nontemporal_store(w, (u32x4*)(j.dst + (size_t)drow * j.ldd + j.dcol0 + k)); } }
    }
    __syncthreads();
#undef TC_LOAD
}
__device__ __forceinline__ bool make_job(int i, PP p, unsigned char* ws, TJob& j) {
    j.g = nullptr; j.mu = nullptr; j.mode = 0; j.cs = 1.0f; j.rowmap = 0; j.drow0 = 0; j.dcol0 = 0; j.c0 = 0;
    if (i < 8) {
        const int bj = i & 1, f = (i >> 1) & 1, l = i >> 2;
        j.src = p->in[f ? 12 : 5] + (size_t)l * 1024 * 5632; j.lds_ = 5632; j.K = 1024; j.N = 2816; j.c0 = bj * 2816;
        j.dst = (bf16_t*)(ws + OFF_WIN + (size_t)(l * 2 + f) * SZ_WIN); j.ldd = 1024; j.rowmap = 1; j.drow0 = bj * 128; j.g = p->in[f ? 11 : 4] + l * 1024; return true; }
    i -= 8;
    if (i < 4) {
        const int f = i & 1, l = i >> 1;
        j.src = p->in[f ? 13 : 6] + (size_t)l * 2816 * 1024; j.lds_ = 1024; j.K = 2816; j.N = 1024; j.dst = (bf16_t*)(ws + OFF_WOUT + (size_t)(l * 2 + f) * SZ_WOUT); j.ldd = 2816; return true; }
    i -= 4;
    if (i < 4) {
        const int o = i & 1, l = i >> 1;
        j.src = p->in[o ? 10 : 9] + (size_t)l * 1024 * 1024; j.lds_ = 1024; j.K = 1024; j.N = 1024; j.dst = (bf16_t*)(ws + (o ? OFF_WO : OFF_WQ) + (size_t)l * SZ_SQ); j.ldd = 1024;
        if (!o) { j.g = p->in[8] + l * 1024; j.cs = 0.0625f; } return true; }
    i -= 4;
    if (i < 2) {
        j.src = p->in[3]; j.lds_ = 2048; j.K = 1024; j.N = 1024; j.c0 = i * 1024; j.dst = (bf16_t*)(ws + (i ? OFF_WMV : OFF_WMK)); j.ldd = 1024; j.g = p->in[2]; return true; }
    i -= 2;
    if (i < 3) {
        j.src = p->in[15]; j.lds_ = 3072; j.K = 1024; j.N = 1024; j.c0 = i * 1024; j.drow0 = i * 1024; j.dst = (bf16_t*)(ws + OFF_WRK); j.ldd = 1024; j.g = p->in[7]; return true; }
    i -= 3;
    if (i < 6) {
        const int half = i & 1, part = i >> 1;
        if (part == 0) { j.src = p->in[17]; j.lds_ = 64; j.N = 64; j.drow0 = 0; }
        else if (part == 1) { j.src = p->in[20]; j.lds_ = 64; j.N = 64; j.drow0 = 64; }
        else { j.src = p->in[22]; j.lds_ = 160; j.N = 160; j.drow0 = 128; }
        const int mi = part == 0 ? 1 : part == 1 ? 4 : 5;
        j.K = 1024; j.dst = (bf16_t*)(ws + OFF_WLO); j.ldd = 2048; j.dcol0 = half ? 1024 : 0; j.g = p->in[7]; j.mu = p->in[14] + mi * 1024; j.mode = half ? 2 : 1; return true; }
    i -= 6;
    if (i == 0) { j.src = p->in[18]; j.lds_ = 1024; j.K = 64; j.N = 1024; j.dst = (bf16_t*)(ws + OFF_W2T); j.ldd = 64; return true; }
    if (i == 1) { j.src = p->in[21]; j.lds_ = 1024; j.K = 64; j.N = 1024; j.dst = (bf16_t*)(ws + OFF_A2T); j.ldd = 64; return true; }
    if (i == 2) { j.src = p->in[23]; j.lds_ = 1024; j.K = 160; j.N = 1024; j.dst = (bf16_t*)(ws + OFF_G2T); j.ldd = 160; return true; }
    if (i == 3) { j.src = p->in[29]; j.lds_ = 1024; j.K = 1024; j.N = 1024; j.dst = (bf16_t*)(ws + OFF_RWO); j.ldd = 1024; return true; }
    if (i == 4) { j.src = p->in[30]; j.lds_ = 4096; j.K = 1024; j.N = 4096; j.dst = (bf16_t*)(ws + OFF_GUV); j.ldd = 1024; j.g = p->in[7] + 1024; return true; }
    if (i == 5) { j.src = p->in[34]; j.lds_ = 1024; j.K = 2048; j.N = 1024; j.dst = (bf16_t*)(ws + OFF_GWO); j.ldd = 2048; return true; }
    return false;
}

__device__ __forceinline__ bool is_late_job(int i) { return (i >= 2 && i < 8) || (i >= 9 && i < 16) || (i >= 30 && i < 33); }
constexpr int LATE_TILES = 73216;
__device__ __forceinline__ void conv_tile8(PP p, unsigned char* ws, int t, int lane) {
    int q, local;
    if (t < 33792) { q = t / 5632; local = t - q * 5632; }
    else if (t < 50688) { const int u = t - 33792; q = u / 5632; local = u - q * 5632; q += 6; }
    else if (t < 58880) { const int u = t - 50688; q = u >> 11; local = u & 2047; q += 9; }
    else if (t < 60928) { q = 13; local = t - 58880; }
    else if (t < 69120) { q = 14; local = t - 60928; }
    else { q = 15; local = t - 69120; }
    TJob j; (void)make_job(q < 6 ? q + 2 : (q < 13 ? q + 3 : q + 17), p, ws, j);
    const int kb = j.K >> 3, nt_ = local / kb, kt = local - nt_ * kb, k0 = kt * 8, n = nt_ * 64 + lane;
    const float* sp = j.src + (size_t)k0 * j.lds_ + j.c0 + n; float v[8];
#pragma unroll
    for (int e = 0; e < 8; ++e) v[e] = sp[(size_t)e * j.lds_];
#pragma unroll
    for (int e = 0; e < 8; ++e) v[e] *= j.g ? j.cs * j.g[k0 + e] : j.cs;
    const int drow = j.drow0 + (j.rowmap ? ((n >> 7) * 256 + (n & 127)) : n);
    u32x4 w; w.x = cvt_pk_bf16(v[0], v[1]); w.y = cvt_pk_bf16(v[2], v[3]); w.z = cvt_pk_bf16(v[4], v[5]); w.w = cvt_pk_bf16(v[6], v[7]);
    *(u32x4*)(j.dst + (size_t)drow * j.ldd + j.dcol0 + k0) = w;
}

__device__ __forceinline__ void phase_prep(const Ctx& cx, PP p, unsigned char* ws) {
    { const float* w = p->in[32]; bf16_t* o = (bf16_t*)(ws + OFF_WS16); for (int i = cx.bid * 512 + cx.tid; i < 16 * 128 * 128; i += cx.G * 512) { const int s = i & 127, t = (i >> 7) & 127; o[i] = (bf16_t)(cvt_pk_bf16(s <= t ? w[i] : 0.f, 0.f) & 0xffffu); } }
    const int gw = cx.bid * 8 + cx.wv, nw = cx.G * 8;
    { const float* x = p->in[0]; bf16_t* xb = (bf16_t*)(ws + OFF_XB); float* ssq0 = (float*)(ws + OFF_SSQ);
        for (int r = gw; r < T; r += nw) { float s = 0.f;
#pragma unroll
            for (int i = 0; i < 4; ++i) { const size_t o = (size_t)r * C + i * 256 + cx.lane * 4; const f32x4 v = *(const f32x4*)(x + o);
                u32x2 w; w.x = cvt_pk_bf16(v[0], v[1]); w.y = cvt_pk_bf16(v[2], v[3]); *(u32x2*)(xb + o) = w; s += (v[0] * v[0] + v[1] * v[1]) + (v[2] * v[2] + v[3] * v[3]); }
#pragma unroll
            for (int o = 32; o >= 1; o >>= 1) s += __shfl_xor(s, o);
            if (cx.lane < 4) ssq0[(size_t)r * 4 + cx.lane] = cx.lane == 0 ? s : 0.f; } }
    { const float* x = p->in[1]; bf16_t* xb = (bf16_t*)(ws + OFF_MEMN);
        for (int r = gw; r < 2048; r += nw) { float s = 0.f; f32x4 v[4];
#pragma unroll
            for (int i = 0; i < 4; ++i) { v[i] = *(const f32x4*)(x + (size_t)r * C + i * 256 + cx.lane * 4); s += (v[i][0] * v[i][0] + v[i][1] * v[i][1]) + (v[i][2] * v[i][2] + v[i][3] * v[i][3]); }
#pragma unroll
            for (int o = 32; o >= 1; o >>= 1) s += __shfl_xor(s, o);
            const float rs = rsqrtf(s * (1.0f / 1024.0f) + RMS_EPS);
#pragma unroll
            for (int i = 0; i < 4; ++i) { u32x2 w; w.x = cvt_pk_bf16(v[i][0] * rs, v[i][1] * rs); w.y = cvt_pk_bf16(v[i][2] * rs, v[i][3] * rs); *(u32x2*)(xb + (size_t)r * C + i * 256 + cx.lane * 4) = w; } } }
    for (int i = 0;; ++i) { TJob j; if (!make_job(i, p, ws, j)) break; if (is_late_job(i)) continue; run_tconv(cx, j); }
}
__device__ __forceinline__ void phase_hn(const Ctx& cx, PP p, unsigned char* ws) {
    const bf16_t* x = (const bf16_t*)(ws + OFF_XB); bf16_t* hn = (bf16_t*)(ws + OFF_BIG + BIG_Y); const float* ssq = (const float*)(ws + OFF_SSQ) + (size_t)1 * T * 4;
    const int gw = cx.bid * 8 + cx.wv, nw = cx.G * 8;
    for (int r = gw; r < T; r += nw) { const int b = r >> 12, s = r & 4095; const float rs = rsqrtf(ssq4(ssq + (size_t)r * 4) * (1.0f / 1024.0f) + RMS_EPS);
        bf16_t* dst = hn + (size_t)(b * 4097 + 1 + s) * C;
#pragma unroll
        for (int i = 0; i < 2; ++i) { const int c = i * 512 + cx.lane * 8; const u32x4 v = *(const u32x4*)(x + (size_t)r * C + c);
            u32x4 w; w.x = cvt_pk_bf16(bf_lo(v.x) * rs, bf_hi(v.x) * rs); w.y = cvt_pk_bf16(bf_lo(v.y) * rs, bf_hi(v.y) * rs); w.z = cvt_pk_bf16(bf_lo(v.z) * rs, bf_hi(v.z) * rs); w.w = cvt_pk_bf16(bf_lo(v.w) * rs, bf_hi(v.w) * rs);
            __builtin_nontemporal_store(w, (u32x4*)(dst + c));
            if (s == 0) { u32x4 z; z.x = 0u; z.y = 0u; z.z = 0u; z.w = 0u; *(u32x4*)(dst - C + c) = z; } } }
}
__device__ __forceinline__ void phase_premix(const Ctx& cx, PP p, unsigned char* ws) {
    const bf16_t* x = (const bf16_t*)(ws + OFF_XB); const float* ssq = (const float*)(ws + OFF_SSQ) + (size_t)1 * T * 4;
    bf16_t* xr = (bf16_t*)p->out; bf16_t* xk = xr + (size_t)T * C; bf16_t* xv = (bf16_t*)(ws + OFF_BIG + BIG_Y);
    bf16_t* hn = (bf16_t*)(ws + OFF_BIG);
    const float* mur = p->in[14]; const float* muk = mur + 2 * 1024; const float* muv = mur + 3 * 1024;
    const int gw = cx.bid * 8 + cx.wv, nw = cx.G * 8;
    for (int r = gw; r < T; r += nw) { const int s_ = r & 4095; const float rs = rsqrtf(ssq4(ssq + (size_t)r * 4) * (1.0f / 1024.0f) + RMS_EPS);
        const float rp = s_ ? rsqrtf(ssq4(ssq + (size_t)(r - 1) * 4) * (1.0f / 1024.0f) + RMS_EPS) : 0.f; const size_t rprev = s_ ? (size_t)(r - 1) : (size_t)r;
#pragma unroll
        for (int i = 0; i < 2; ++i) { const int c = i * 512 + cx.lane * 8; const u32x4 vc = *(const u32x4*)(x + (size_t)r * C + c), vp = *(const u32x4*)(x + rprev * C + c);
            float h[8], d[8];
#pragma unroll
            for (int e = 0; e < 4; ++e) { h[2 * e] = bf_lo(vc[e]) * rs; h[2 * e + 1] = bf_hi(vc[e]) * rs; d[2 * e] = bf_lo(vp[e]) * rp - h[2 * e]; d[2 * e + 1] = bf_hi(vp[e]) * rp - h[2 * e + 1]; }
            { u32x4 wh; wh.x = cvt_pk_bf16(h[0], h[1]); wh.y = cvt_pk_bf16(h[2], h[3]); wh.z = cvt_pk_bf16(h[4], h[5]); wh.w = cvt_pk_bf16(h[6], h[7]);
                bf16_t* dsth = hn + (size_t)((r >> 12) * 4097 + 1 + s_) * C + c; __builtin_nontemporal_store(wh, (u32x4*)dsth);
                if (s_ == 0) { unsigned zz = 0u; asm volatile("" : "+v"(zz)); u32x4 z; z.x = zz; z.y = zz; z.z = zz; z.w = zz; *(u32x4*)(dsth - C) = z; } }
            const f32x4 a0 = *(const f32x4*)(mur + c), a1 = *(const f32x4*)(mur + c + 4), b0 = *(const f32x4*)(muk + c), b1 = *(const f32x4*)(muk + c + 4), c0 = *(const f32x4*)(muv + c), c1 = *(const f32x4*)(muv + c + 4);
            u32x4 wr_, wk_, wv_;
#pragma unroll
            for (int e = 0; e < 4; ++e) { const float m0r = e < 2 ? a0[2 * e] : a1[2 * e - 4], m1r = e < 2 ? a0[2 * e + 1] : a1[2 * e - 3], m0k = e < 2 ? b0[2 * e] : b1[2 * e - 4], m1k = e < 2 ? b0[2 * e + 1] : b1[2 * e - 3];
                const float m0v = e < 2 ? c0[2 * e] : c1[2 * e - 4], m1v = e < 2 ? c0[2 * e + 1] : c1[2 * e - 3];
                wr_[e] = cvt_pk_bf16(h[2 * e] + d[2 * e] * m0r, h[2 * e + 1] + d[2 * e + 1] * m1r); wk_[e] = cvt_pk_bf16(h[2 * e] + d[2 * e] * m0k, h[2 * e + 1] + d[2 * e + 1] * m1k);
                wv_[e] = cvt_pk_bf16(h[2 * e] + d[2 * e] * m0v, h[2 * e + 1] + d[2 * e + 1] * m1v); }
            __builtin_nontemporal_store(wr_, (u32x4*)(xr + (size_t)r * C + c)); __builtin_nontemporal_store(wk_, (u32x4*)(xk + (size_t)r * C + c)); __builtin_nontemporal_store(wv_, (u32x4*)(xv + (size_t)r * C + c)); } }
}
__device__ __forceinline__ void phase_final(const Ctx& cx, PP p, unsigned char* ws) {
    const bf16_t* x = (const bf16_t*)(ws + OFF_XB); float* out = p->out; const float* ssq = (const float*)(ws + OFF_SSQ) + (size_t)8 * T * 4; const float* gf = p->in[35];
    const int gw = cx.bid * 8 + cx.wv, nw = cx.G * 8;
    for (int r = gw; r < T; r += nw) { const float rs = rsqrtf(ssq4(ssq + (size_t)r * 4) * (1.0f / 1024.0f) + RMS_EPS);
#pragma unroll
        for (int i = 0; i < 2; ++i) { const int c = i * 512 + cx.lane * 8; const u32x4 v = *(const u32x4*)(x + (size_t)r * C + c); const f32x4 g0 = *(const f32x4*)(gf + c), g1 = *(const f32x4*)(gf + c + 4);
            const f32x4 o0 = (f32x4){bf_lo(v.x), bf_hi(v.x), bf_lo(v.y), bf_hi(v.y)} * rs * g0, o1 = (f32x4){bf_lo(v.z), bf_hi(v.z), bf_lo(v.w), bf_hi(v.w)} * rs * g1;
            __builtin_nontemporal_store(o0, (f32x4*)(out + (size_t)r * C + c)); __builtin_nontemporal_store(o1, (f32x4*)(out + (size_t)r * C + c + 4)); } }
}

constexpr int SC_BUF = 6 * 2048;
constexpr int SC_Y = 2 * SC_BUF;
constexpr int SC_W2 = (SC_Y + 2048) * 4;
constexpr int SC_A2 = SC_W2 + 64 * 144, SC_G2 = SC_A2 + 64 * 144, SC_CONST = SC_G2 + 64 * 336, SC_END = SC_CONST + 5 * 256;
static_assert(SC_END <= LDS_BYTES, "scan LDS");
__device__ __forceinline__ void phase_scan(const Ctx& cx, PP p, unsigned char* ws) {
    const bf16_t* RK = (const bf16_t*)(ws + OFF_BIG); bf16_t* Y = (bf16_t*)(ws + OFF_BIG + BIG_Y); bf16_t* Gt = (bf16_t*)p->out;
    float* bonus = (float*)(ws + OFF_BONUS); f32x2* gnst = (f32x2*)(ws + OFF_GNST);
    const bf16_t* W2T = (const bf16_t*)(ws + OFF_W2T); const bf16_t* A2T = (const bf16_t*)(ws + OFF_A2T); const bf16_t* G2T = (const bf16_t*)(ws + OFF_G2T);
    LAS float* sF = (LAS float*)cx.lds; LAS float* sY = sF + SC_Y; LAS float* sC = (LAS float*)(cx.lds + SC_CONST);
    const int tid = cx.tid, lane = cx.lane, wv = cx.wv, fr = lane & 15, fq = lane >> 4;
    const int irow = (wv & 3) * 8 + (lane >> 4) * 2, seg = lane & 15;
    int wtile = cx.bid * 2 + (wv - 6);
    for (int unit = cx.bid; unit < 256; unit += cx.G) {
        const int half = (unit >> 3) & 1, chain = (unit & 7) + 8 * (unit >> 4), b = chain >> 4, h = chain & 15, tok0 = b * SEQ;
        LBAR();
        for (int i = tid; i < 64 * 8; i += 512) { const int r = i >> 3, q = i & 7; *(LAS u32x4*)(cx.lds + SC_W2 + r * 144 + q * 16) = *(const u32x4*)(W2T + (size_t)(h * 64 + r) * 64 + q * 8);
            *(LAS u32x4*)(cx.lds + SC_A2 + r * 144 + q * 16) = *(const u32x4*)(A2T + (size_t)(h * 64 + r) * 64 + q * 8); }
        for (int i = tid; i < 64 * 20; i += 512) { const int r = i / 20, q = i % 20; *(LAS u32x4*)(cx.lds + SC_G2 + r * 336 + q * 16) = *(const u32x4*)(G2T + (size_t)(h * 64 + r) * 160 + q * 8); }
        if (tid < 320) { const int a = tid >> 6, c = tid & 63; const float* src = a == 0 ? p->in[16] : a == 1 ? p->in[19] : a == 2 ? p->in[24] : a == 3 ? p->in[25] : p->in[26]; sC[a * 64 + c] = src[h * 64 + c]; }
        LBAR();
        if (wv < 4) {
        f32x2 sA0 = (f32x2){0.f, 0.f}, sA1 = sA0, sB0 = sA0, sB1 = sA0;
            for (int c = -1; c < SEQ / 32 + 1; ++c) {
                if (c >= 0) LBAR();
                if (c >= 0 && c < SEQ / 32) {
                    __builtin_amdgcn_s_setprio(3);
                    LAS float* buf = sF + (c & 1) * SC_BUF; LAS float* yo = sY + (c & 1) * 1024;
                    const LAS float* bp = buf + seg * 4; const LAS float* vp = buf + 5 * 2048 + half * 32 + irow;
                    f32x4 cw = *(const LAS f32x4*)(bp), cq = *(const LAS f32x4*)(bp + 1 * 2048), cb = *(const LAS f32x4*)(bp + 2 * 2048), ck = *(const LAS f32x4*)(bp + 3 * 2048), cr = *(const LAS f32x4*)(bp + 4 * 2048);
                    f32x2 cv = *(const LAS f32x2*)(vp);
#pragma unroll 1
                    for (int hb = 0; hb < 2; ++hb) { float PA[16], PB[16];
#pragma unroll
                        for (int i = 0; i < 16; ++i) { const int tn = (hb * 16 + i + 1) & 31; const LAS float* np_ = bp + tn * 64;
                            const f32x4 nw = *(const LAS f32x4*)(np_), nq = *(const LAS f32x4*)(np_ + 1 * 2048), nb = *(const LAS f32x4*)(np_ + 2 * 2048), nk = *(const LAS f32x4*)(np_ + 3 * 2048), nr = *(const LAS f32x4*)(np_ + 4 * 2048);
                            const f32x2 nv = *(const LAS f32x2*)(vp + tn * 64);
                            const f32x2 q0 = (f32x2){cq[0], cq[1]}, q1 = (f32x2){cq[2], cq[3]}, w0 = (f32x2){cw[0], cw[1]}, w1 = (f32x2){cw[2], cw[3]}, b0 = (f32x2){cb[0], cb[1]}, b1 = (f32x2){cb[2], cb[3]};
                            const f32x2 k0 = (f32x2){ck[0], ck[1]}, k1 = (f32x2){ck[2], ck[3]}, r0 = (f32x2){cr[0], cr[1]}, r1 = (f32x2){cr[2], cr[3]};
                            f32x2 ta = sA0 * q0; ta += sA1 * q1; f32x2 tb = sB0 * q0; tb += sB1 * q1;
                            float saA = ta[0] + ta[1], saB = tb[0] + tb[1];
                            fred16x2(saA, saB);
                            const f32x2 vA = (f32x2){cv[0], cv[0]}, vB = (f32x2){cv[1], cv[1]}, nA = (f32x2){-saA, -saA}, nB = (f32x2){-saB, -saB};
                            sA0 = sA0 * w0 + vA * k0; sA1 = sA1 * w1 + vA * k1; sB0 = sB0 * w0 + vB * k0; sB1 = sB1 * w1 + vB * k1;
                            sA0 += nA * b0; sA1 += nA * b1; sB0 += nB * b0; sB1 += nB * b1;
                            f32x2 ya = sA0 * r0; ya += sA1 * r1; f32x2 yb = sB0 * r0; yb += sB1 * r1;
                            PA[i] = ya[0] + ya[1]; PB[i] = yb[0] + yb[1];
                            cw = nw; cq = nq; cb = nb; ck = nk; cr = nr; cv = nv; }
                        const float yA = treduce16(PA, lane), yB = treduce16(PB, lane);
                        *(LAS f32x2*)(yo + (hb * 16 + seg) * 32 + irow) = (f32x2){yA, yB}; }
                    __builtin_amdgcn_s_setprio(0); }
            }
        } else if (wv < 6) {
        bf16x8 aw[2], aa[2], ag[5]; u32x2 rr[4], kr[4], vr[4];
#define SC_PLOAD(cn_) do { const size_t tok_ = (size_t)(tok0 + (cn_) * 32 + (wv - 4) * 16 + fr); const bf16_t* lp_ = (const bf16_t*)(ws + OFF_BIG + BIG_L) + tok_ * NLO + fq * 8; const bf16_t* rp_ = RK + tok_ * NRK + h * 64 + fq * 4; \
            _Pragma("unroll") for (int ks = 0; ks < 2; ++ks) { aw[ks] = *(const bf16x8*)(lp_ + ks * 32); aa[ks] = *(const bf16x8*)(lp_ + 64 + ks * 32); } \
            _Pragma("unroll") for (int ks = 0; ks < 5; ++ks) ag[ks] = *(const bf16x8*)(lp_ + 128 + ks * 32); \
            _Pragma("unroll") for (int cb = 0; cb < 4; ++cb) { rr[cb] = *(const u32x2*)(rp_ + cb * 16); kr[cb] = *(const u32x2*)(rp_ + 1024 + cb * 16); vr[cb] = *(const u32x2*)(rp_ + 2048 + cb * 16); } } while (0)
            SC_PLOAD(0);
            for (int c = -1; c < SEQ / 32 + 1; ++c) {
                if (c >= 0) LBAR();
                const int cn = c + 1;
                if (cn < SEQ / 32) {
                    LAS float* buf = sF + (cn & 1) * SC_BUF; const int pw = wv - 4, tl = pw * 16 + fr; const size_t tok = (size_t)(tok0 + cn * 32 + tl);
                    float ssq = 0.f, bo = 0.f;
#pragma unroll
                    for (int cb = 0; cb < 4; ++cb) {
                        f32x4 cw = (f32x4){0.f, 0.f, 0.f, 0.f}, ca = cw, cgv = cw; const int brow = cb * 16 + fr;
#pragma unroll
                        for (int ks = 0; ks < 2; ++ks) { cw = __builtin_amdgcn_mfma_f32_16x16x32_bf16(*(const LAS bf16x8*)(cx.lds + SC_W2 + brow * 144 + ks * 64 + fq * 16), aw[ks], cw, 0, 0, 0);
                            ca = __builtin_amdgcn_mfma_f32_16x16x32_bf16(*(const LAS bf16x8*)(cx.lds + SC_A2 + brow * 144 + ks * 64 + fq * 16), aa[ks], ca, 0, 0, 0); }
#pragma unroll
                        for (int ks = 0; ks < 5; ++ks) cgv = __builtin_amdgcn_mfma_f32_16x16x32_bf16(*(const LAS bf16x8*)(cx.lds + SC_G2 + brow * 336 + ks * 64 + fq * 16), ag[ks], cgv, 0, 0, 0);
                        const int c0 = cb * 16 + fq * 4;
                        const f32x4 w04 = *(const LAS f32x4*)(sC + c0), a04 = *(const LAS f32x4*)(sC + 64 + c0), kk4 = *(const LAS f32x4*)(sC + 128 + c0), ka4 = *(const LAS f32x4*)(sC + 192 + c0), rk4 = *(const LAS f32x4*)(sC + 256 + c0);
                        f32x4 dec, a4;
#pragma unroll
                        for (int e = 0; e < 4; ++e) { dec[e] = __expf(-0.6065306597f * sigmoidf_(w04[e] + cw[e])); a4[e] = sigmoidf_(a04[e] + ca[e]); }
                        const f32x4 r4 = (f32x4){bf_lo(rr[cb].x), bf_hi(rr[cb].x), bf_lo(rr[cb].y), bf_hi(rr[cb].y)}, k4 = (f32x4){bf_lo(kr[cb].x), bf_hi(kr[cb].x), bf_lo(kr[cb].y), bf_hi(kr[cb].y)};
                        const f32x4 v4 = (f32x4){bf_lo(vr[cb].x), bf_hi(vr[cb].x), bf_lo(vr[cb].y), bf_hi(vr[cb].y)};
                        const f32x4 kq = k4 * kk4; ssq += (kq[0] * kq[0] + kq[1] * kq[1]) + (kq[2] * kq[2] + kq[3] * kq[3]);
                        const f32x4 kn = k4 * (1.0f + (a4 - 1.0f) * ka4);
                        bo += (r4[0] * kn[0] * rk4[0] + r4[1] * kn[1] * rk4[1]) + (r4[2] * kn[2] * rk4[2] + r4[3] * kn[3] * rk4[3]);
                        const int o = tl * 64 + c0;
                        *(LAS f32x4*)(buf + o) = dec; *(LAS f32x4*)(buf + 3 * 2048 + o) = kn; *(LAS f32x4*)(buf + 4 * 2048 + o) = r4; *(LAS f32x4*)(buf + 5 * 2048 + o) = v4;
                        *(LAS f32x4*)(buf + 1 * 2048 + o) = kq; *(LAS f32x4*)(buf + 2 * 2048 + o) = kq * a4;
                        if ((cb >> 1) == half) { u32x2 w; w.x = cvt_pk_bf16(cgv[0], cgv[1]); w.y = cvt_pk_bf16(cgv[2], cgv[3]); __builtin_nontemporal_store(w, (u32x2*)(Gt + tok * C + h * 64 + c0)); } }
                    ssq += __shfl_xor(ssq, 16); ssq += __shfl_xor(ssq, 32); bo += __shfl_xor(bo, 16); bo += __shfl_xor(bo, 32);
                    const float inv = 1.0f / fmaxf(sqrtf(ssq), 1e-12f);
#pragma unroll
                    for (int cb = 0; cb < 4; ++cb) { const int o = tl * 64 + cb * 16 + fq * 4; const f32x4 kq = *(const LAS f32x4*)(buf + 1 * 2048 + o) * inv, bq = *(const LAS f32x4*)(buf + 2 * 2048 + o) * inv; *(LAS f32x4*)(buf + 1 * 2048 + o) = kq; *(LAS f32x4*)(buf + 2 * 2048 + o) = bq; }
                    if (half == 0 && fq == 0) bonus[tok * 16 + h] = bo;
                    if (cn + 1 < SEQ / 32) SC_PLOAD(cn + 1); }
            }
        } else {
            for (int c = -1; c < SEQ / 32 + 1; ++c) {
                if (c >= 0) LBAR();
                const int co = c - 1;
                if (co >= 0) { const LAS float* yi = sY + (co & 1) * 1024; const int ow = wv - 6, tl = ow * 16 + (lane >> 2), r8 = (lane & 3) * 8; const size_t tok = (size_t)(tok0 + co * 32 + tl);
                    const f32x4 y0 = *(const LAS f32x4*)(yi + tl * 32 + r8), y1 = *(const LAS f32x4*)(yi + tl * 32 + r8 + 4);
                    u32x4 w; w.x = cvt_pk_bf16(y0[0], y0[1]); w.y = cvt_pk_bf16(y0[2], y0[3]); w.z = cvt_pk_bf16(y1[0], y1[1]); w.w = cvt_pk_bf16(y1[2], y1[3]);
                    __builtin_nontemporal_store(w, (u32x4*)(Y + tok * C + h * 64 + half * 32 + r8));
                    float s1 = ((y0[0] + y0[1]) + (y0[2] + y0[3])) + ((y1[0] + y1[1]) + (y1[2] + y1[3]));
                    float s2 = ((y0[0] * y0[0] + y0[1] * y0[1]) + (y0[2] * y0[2] + y0[3] * y0[3])) + ((y1[0] * y1[0] + y1[1] * y1[1]) + (y1[2] * y1[2] + y1[3] * y1[3]));
                    s1 += dppf<0xB1>(s1); s1 += dppf<0x4E>(s1); s2 += dppf<0xB1>(s2); s2 += dppf<0x4E>(s2);
                    if ((lane & 3) == 0) gnst[(tok * 16 + h) * 2 + half] = (f32x2){s1, s2}; }
#pragma unroll 1
                for (int q2 = 0; q2 < 2; ++q2) if (wtile < LATE_TILES) { conv_tile8(p, ws, wtile, lane); wtile += cx.G * 2; }
            }
        }
    }
#undef SC_PLOAD
    if (wv >= 6) { while (wtile < LATE_TILES) { conv_tile8(p, ws, wtile, lane); wtile += cx.G * 2; } }
    LBAR();
}
__device__ __forceinline__ void phase_post(const Ctx& cx, PP p, unsigned char* ws) {
    const bf16_t* RK = (const bf16_t*)(ws + OFF_BIG); bf16_t* Y = (bf16_t*)(ws + OFF_BIG + BIG_Y); const bf16_t* Gt = (const bf16_t*)p->out;
    const float* bonus = (const float*)(ws + OFF_BONUS); const f32x4* gnst = (const f32x4*)(ws + OFF_GNST);
    const float* lnw = p->in[27]; const float* lnb = p->in[28];
    for (int i = cx.bid * 512 + cx.tid; i < T * 128; i += cx.G * 512) {
        const int t = i >> 7, c8 = (i & 127) * 8, h = c8 >> 6;
        const f32x4 stt = gnst[(size_t)t * 16 + h]; const float mean = (stt[0] + stt[2]) * (1.0f / 64.0f); const float var = fmaxf((stt[1] + stt[3]) * (1.0f / 64.0f) - mean * mean, 0.f);
        const float rs = rsqrtf(var + 64e-5f); const float bo = bonus[(size_t)t * 16 + h];
        const u32x4 yv = *(const u32x4*)(Y + (size_t)t * C + c8), gv = *(const u32x4*)(Gt + (size_t)t * C + c8), vv = *(const u32x4*)(RK + (size_t)t * NRK + 2048 + c8);
        const f32x4 lw0 = *(const f32x4*)(lnw + c8), lw1 = *(const f32x4*)(lnw + c8 + 4), lb0 = *(const f32x4*)(lnb + c8), lb1 = *(const f32x4*)(lnb + c8 + 4);
        float o[8];
#pragma unroll
        for (int e = 0; e < 4; ++e) { const unsigned yw = yv[e], gw = gv[e], vw = vv[e];
            const float l0 = e < 2 ? lw0[2 * e] : lw1[2 * e - 4], l1 = e < 2 ? lw0[2 * e + 1] : lw1[2 * e - 3], c0 = e < 2 ? lb0[2 * e] : lb1[2 * e - 4], c1 = e < 2 ? lb0[2 * e + 1] : lb1[2 * e - 3];
            o[2 * e] = ((bf_lo(yw) - mean) * rs * l0 + c0 + bo * bf_lo(vw)) * bf_lo(gw);
            o[2 * e + 1] = ((bf_hi(yw) - mean) * rs * l1 + c1 + bo * bf_hi(vw)) * bf_hi(gw); }
        u32x4 w; w.x = cvt_pk_bf16(o[0], o[1]); w.y = cvt_pk_bf16(o[2], o[3]); w.z = cvt_pk_bf16(o[4], o[5]); w.w = cvt_pk_bf16(o[6], o[7]);
        __builtin_nontemporal_store(w, (u32x4*)(Y + (size_t)t * C + c8));
    }
}
__device__ __forceinline__ void phase_spatial(const Ctx& cx, PP p, unsigned char* ws) {
    bf16_t* U = (bf16_t*)(ws + OFF_BIG); const bf16_t* V = (const bf16_t*)(ws + OFF_BIG + BIG_V); const bf16_t* WS16 = (const bf16_t*)(ws + OFF_WS16);
    const float* ssqv = (const float*)(ws + OFF_SSQV); const float* vnorm = p->in[31]; const float* bs = p->in[33];
    LAS unsigned char* sAw = cx.lds;
    LAS unsigned char* sVt = cx.lds + 128 * 272;
    LAS float* sRs = (LAS float*)(cx.lds + 128 * 272 + 128 * 260);
    const int tid = cx.tid, lane = cx.lane, wv = cx.wv, fr = lane & 15, fq = lane >> 4;
    int gl = -1;
    for (int unit = cx.bid; unit < 4096; unit += cx.G) {
        const int g = unit & 15, bc = unit >> 4; const int tok0 = bc * 128;
        LBAR();
        if (tid < 128) sRs[tid] = rsqrtf((ssq16(ssqv + (size_t)(tok0 + tid) * 32) + ssq16(ssqv + (size_t)(tok0 + tid) * 32 + 16)) * (1.0f / 2048.0f) + RMS_EPS);
        if (g != gl) { gl = g;
#pragma unroll
            for (int it = 0; it < 4; ++it) { const int idx = tid + it * 512, t = idx >> 4, sg = idx & 15; const u32x4 w = *(const u32x4*)(WS16 + (size_t)g * 16384 + t * 128 + sg * 8); *(LAS u32x4*)(sAw + t * 272 + sg * 16) = w; } }
        u32x4 vw[4];
#pragma unroll
        for (int it = 0; it < 4; ++it) { const int idx = tid + it * 512, s = idx >> 4, dg = idx & 15; vw[it] = *(const u32x4*)(V + (size_t)(tok0 + s) * 2048 + g * 128 + dg * 8); }
        LBAR();
#pragma unroll
        for (int it = 0; it < 4; ++it) { const int idx = tid + it * 512, s = idx >> 4, dg = idx & 15;
            const u32x4 w = vw[it]; const float rs = sRs[s];
            LAS unsigned* d = (LAS unsigned*)(sVt + s * 260 + dg * 16);
            d[0] = cvt_pk_bf16(bf_lo(w.x) * rs, bf_hi(w.x) * rs); d[1] = cvt_pk_bf16(bf_lo(w.y) * rs, bf_hi(w.y) * rs); d[2] = cvt_pk_bf16(bf_lo(w.z) * rs, bf_hi(w.z) * rs); d[3] = cvt_pk_bf16(bf_lo(w.w) * rs, bf_hi(w.w) * rs); }
        LBAR();
        bf16x8 bf[4];
#pragma unroll
        for (int ks = 0; ks < 4; ++ks)
#pragma unroll
            for (int e = 0; e < 8; ++e) bf[ks][e] = (short)*(const LAS unsigned short*)(sVt + (ks * 32 + fq * 8 + e) * 260 + (wv * 16 + fr) * 2);
        const int d4 = g * 128 + wv * 16 + fq * 4; const f32x4 vn4 = *(const f32x4*)(vnorm + d4);
        u32x2 uwv[8]; float bsa[8];
#pragma unroll
        for (int m = 0; m < 8; ++m) { const int t = m * 16 + fr; uwv[m] = *(const u32x2*)(U + (size_t)(tok0 + t) * 2048 + d4); bsa[m] = bs[g * 128 + t]; }
#pragma unroll
        for (int m = 0; m < 8; ++m) { f32x4 acc = (f32x4){0.f, 0.f, 0.f, 0.f};
#pragma unroll
            for (int ks = 0; ks < 4; ++ks) if (ks <= m / 2) { const bf16x8 af = *(const LAS bf16x8*)(sAw + (m * 16 + fr) * 272 + (ks * 32 + fq * 8) * 2); acc = __builtin_amdgcn_mfma_f32_16x16x32_bf16(bf[ks], af, acc, 0, 0, 0); }
            const int t = m * 16 + fr; const float bsv = bsa[m]; bf16_t* up = U + (size_t)(tok0 + t) * 2048 + d4; const u32x2 uw = uwv[m];
            const f32x4 sv = acc * vn4 + bsv; u32x2 w; w.x = cvt_pk_bf16(bf_lo(uw.x) * sv[0], bf_hi(uw.x) * sv[1]); w.y = cvt_pk_bf16(bf_lo(uw.y) * sv[2], bf_hi(uw.y) * sv[3]); __builtin_nontemporal_store(w, (u32x2*)up); }
    }
    LBAR();
}
__device__ __forceinline__ void phase_xattn(const Ctx& cx, PP p, unsigned char* ws) {
    const bf16_t* Q = (const bf16_t*)(ws + OFF_BIG); bf16_t* O = (bf16_t*)(ws + OFF_BIG + BIG_O); bf16_t* P = (bf16_t*)(ws + OFF_BIG + BIG_P) + (size_t)cx.bid * 65536;
    const bf16_t* MK = (const bf16_t*)(ws + OFF_MK); const bf16_t* VT = (const bf16_t*)(ws + OFF_VT);
    for (int unit = cx.bid; unit < 512; unit += cx.G) {
        const int pm = unit >> 2, h = unit & 3, b = pm >> 4; int kk = 256; asm volatile("" : "+s"(kk));
        { pg8::Gemm g{Q + (size_t)pm * 256 * C + h * 256, MK + (size_t)b * 256 * C + h * 256, 256, 256, kk, C, C, 0, nullptr, nullptr}; pg8::SingleUnit S; pg8::EpiSoftmax E{P};
            pg8::gemm_phase<pg8::EpiSoftmax, pg8::SingleUnit>(cx.lds, g, S, E); }
        __syncthreads();
        { pg8::Gemm g{P, VT + (size_t)h * 256 * 2048 + b * 256, 256, 256, kk, 256, 2048, 0, nullptr, nullptr}; pg8::SingleUnit S; pg8::EpiB<0> E{O, C, pm * 256, h * 256, nullptr, nullptr, nullptr};
            pg8::gemm_phase<pg8::EpiB<0>, pg8::SingleUnit>(cx.lds, g, S, E); }
        __syncthreads();
    }
}

#define XB_TMO      128
#define XB_XCNT(j)  (256  + 64 * (j))
#define XB_XSUB(j)  (1280 + 64 * (j))
#define XB_XGEN(j)  (2304 + 64 * (j))
#define XB_TOP      3328
#define XB_TOPGEN   3392
#define XCD_BAR_WORDS 3456
#define XB_SPIN_CAP (1u << 18)
__device__ __forceinline__ unsigned xb_ld(unsigned* p)              { return __hip_atomic_load(p, __ATOMIC_RELAXED, __HIP_MEMORY_SCOPE_AGENT); }
__device__ __forceinline__ unsigned xb_add(unsigned* p, unsigned v) { return __hip_atomic_fetch_add(p, v, __ATOMIC_RELAXED, __HIP_MEMORY_SCOPE_AGENT); }
__device__ __forceinline__ unsigned xb_xcc_id() { return (unsigned)__builtin_amdgcn_s_getreg((3 << 11) | 20) & 0xFu; }
#define XB_SPIN(cond, bar) do { unsigned _sp = 0; while (cond) { __builtin_amdgcn_s_sleep(1); \
    if ((++_sp & 255u) == 0u) { if (xb_ld(&(bar)[XB_TMO])) break; if (_sp > XB_SPIN_CAP) { atomicAdd(&(bar)[XB_TMO], 1u); break; } } } } while (0)
struct XcdBarrier { unsigned* bar; unsigned x; volatile LAS unsigned* st; };
__device__ __forceinline__ XcdBarrier xcd_barrier_post(unsigned* bar, volatile LAS unsigned* st) {
    XcdBarrier b; b.bar = bar; b.x = xb_xcc_id(); b.st = st;
    if (threadIdx.x == 0) (void)xb_add(&bar[XB_XCNT(b.x)], 1u);
    return b;
}
__device__ __forceinline__ void xcd_barrier_complete(unsigned* bar, unsigned x, unsigned& nloc, unsigned& nx) {
    const unsigned G = gridDim.x * gridDim.y * gridDim.z;
    unsigned sum, cnt, mine, sp = 0u;
    for (;;) {
        sum = 0u; cnt = 0u; mine = 0u;
#pragma unroll
        for (unsigned j = 0; j < 16; ++j) { const unsigned c = xb_ld(&bar[XB_XCNT(j)]); sum += c; cnt += (c > 0u) ? 1u : 0u; mine = (j == x) ? c : mine; }
        if (sum == G) break;
        __builtin_amdgcn_s_sleep(1);
        if ((++sp & 255u) == 0u) { if (xb_ld(&bar[XB_TMO])) break; if (sp > XB_SPIN_CAP) { atomicAdd(&bar[XB_TMO], 1u); break; } }
    }
    nloc = mine > 0u ? mine : 1u; nx = cnt > 0u ? cnt : 1u;
}
__device__ __forceinline__ void xcd_barrier(const XcdBarrier& b) {
    asm volatile("s_waitcnt vmcnt(0)" ::: "memory");
    __syncthreads();
    if (threadIdx.x == 0) {
        unsigned* bar = b.bar;
        __builtin_amdgcn_s_waitcnt(0);
        unsigned nloc = b.st[0], nx = b.st[1];
        if (nloc == 0u) { xcd_barrier_complete(bar, b.x, nloc, nx); b.st[0] = nloc; b.st[1] = nx; }
        const unsigned old = xb_add(&bar[XB_XSUB(b.x)], 1u);
        const unsigned gen = old / nloc;
        if (old + 1u == (gen + 1u) * nloc) {
            __builtin_amdgcn_fence(__ATOMIC_RELEASE, "agent");
            asm volatile("s_waitcnt vmcnt(0)" ::: "memory");
            const unsigned og = xb_add(&bar[XB_TOP], 1u);
            const unsigned tg = og / nx;
            if (og + 1u == (tg + 1u) * nx) xb_add(&bar[XB_TOPGEN], 1u);
            else XB_SPIN(xb_ld(&bar[XB_TOPGEN]) == tg, bar);
            __builtin_amdgcn_fence(__ATOMIC_ACQUIRE, "agent");
            xb_add(&bar[XB_XGEN(b.x)], 1u);
            asm volatile("s_waitcnt vmcnt(0)" ::: "memory");
        } else {
            XB_SPIN(xb_ld(&bar[XB_XGEN(b.x)]) == gen, bar);
            __builtin_amdgcn_fence(__ATOMIC_ACQUIRE, "agent");
            asm volatile("s_waitcnt vmcnt(0)" ::: "memory");
        }
    }
    __syncthreads();
}

enum { OP_PREP, OP_MEMKV_FFNIN, OP_FFN_IN, OP_FFN_OUT, OP_HN, OP_RWKV_PROJ, OP_SCAN, OP_POST, OP_RWKV_OUT, OP_XQ, OP_XATT, OP_XO, OP_G1, OP_SPATIAL, OP_G3, OP_FINAL, OP_LORA, OP_PREMIX };
constexpr int NPHASE = 25;

__global__ void __launch_bounds__(512, 2) fwd_kernel(Params p_) {
    extern __shared__ __attribute__((aligned(16))) unsigned char smem[];
    cg::grid_group grid = cg::this_grid();
    { volatile LAS unsigned* stw = (volatile LAS unsigned*)((LAS unsigned char*)smem + LDS_BAR); if (threadIdx.x < 4) stw[threadIdx.x] = 0u; }
    __syncthreads();
    XcdBarrier xbar = xcd_barrier_post((unsigned*)(p_.ws + OFF_BAR), (volatile LAS unsigned*)((LAS unsigned char*)smem + LDS_BAR));
    int rep = 0;
    for (int ph = p_.ph_lo; ph < p_.ph_hi; ++ph) {
        PP p = (PP)__builtin_amdgcn_kernarg_segment_ptr(); asm volatile("" : "+s"(p));
        int tid_ = threadIdx.x; asm volatile("" : "+v"(tid_));
        Ctx cx; cx.tid = tid_; cx.lane = cx.tid & 63; cx.wv = __builtin_amdgcn_readfirstlane(cx.tid >> 6); { int g_ = gridDim.x, b_ = blockIdx.x; asm volatile("" : "+s"(g_), "+s"(b_)); cx.G = g_; cx.bid = b_; }
        cx.lds = (LAS unsigned char*)smem;
        unsigned char* ws = p->ws;
        float* ssqb = (float*)(ws + OFF_SSQ);
        bf16_t* XB = (bf16_t*)(ws + OFF_XB); bf16_t* BIG = (bf16_t*)(ws + OFF_BIG);
        int op, l = 0, f = 0;
        switch (ph) {
            case 0: op = OP_PREP; break;
            case 1: op = OP_MEMKV_FFNIN; break;
            case 2: op = OP_FFN_OUT; break;
            case 3: op = OP_PREMIX; break;
            case 4: op = OP_LORA; break;
            case 5: op = OP_RWKV_PROJ; break;
            case 6: op = OP_SCAN; break;
            case 7: op = OP_POST; break;
            case 8: op = OP_RWKV_OUT; break;
            case 9: op = OP_XQ; break;
            case 10: op = OP_XATT; break;
            case 11: op = OP_XO; break;
            case 12: op = OP_FFN_IN; f = 1; break;
            case 13: op = OP_FFN_OUT; f = 1; break;
            case 14: op = OP_FFN_IN; l = 1; break;
            case 15: op = OP_FFN_OUT; l = 1; break;
            case 16: op = OP_G1; l = 1; break;
            case 17: op = OP_SPATIAL; l = 1; break;
            case 18: op = OP_G3; l = 1; break;
            case 19: op = OP_XQ; l = 1; break;
            case 20: op = OP_XATT; l = 1; break;
            case 21: op = OP_XO; l = 1; break;
            case 22: op = OP_FFN_IN; l = 1; f = 1; break;
            case 23: op = OP_FFN_OUT; l = 1; f = 1; break;
            default: op = OP_FINAL; break;
        }
        if (EN(OP_PREP) && op == OP_PREP) phase_prep(cx, p, ws);
        if (EN(OP_MEMKV_FFNIN) && op == OP_MEMKV_FFNIN) {
            { pg8::Gemm g{(const bf16_t*)(ws + OFF_MEMN), (const bf16_t*)(ws + OFF_WMK), 2048, 1024, 1024, 1024, 1024, 0, nullptr, nullptr}; pg8::StaticOrder S; S.init(2048, 1024, cx.G, cx.bid);
                pg8::EpiB<0> E{(bf16_t*)(ws + OFF_MK), 1024, 0, 0, nullptr, nullptr, nullptr}; pg8::gemm_phase<pg8::EpiB<0>, pg8::StaticOrder>(cx.lds, g, S, E); }
            { pg8::Gemm g{(const bf16_t*)(ws + OFF_WMV), (const bf16_t*)(ws + OFF_MEMN), 1024, 2048, 1024, 1024, 1024, 0, nullptr, nullptr}; pg8::StaticOrder S; S.init(1024, 2048, cx.G, (cx.bid + cx.G / 2) % cx.G);
                pg8::EpiB<0> E{(bf16_t*)(ws + OFF_VT), 2048, 0, 0, nullptr, nullptr, nullptr}; pg8::gemm_phase<pg8::EpiB<0>, pg8::StaticOrder>(cx.lds, g, S, E); }
        }
        if (EN(OP_FFN_IN) && (op == OP_MEMKV_FFNIN || op == OP_FFN_IN)) {
            pg8::Gemm g{XB, (const bf16_t*)(ws + OFF_WIN + (size_t)(l * 2 + f) * SZ_WIN), T, 5632, 1024, 1024, 1024, 0, nullptr, nullptr}; pg8::StaticOrder S; S.init(T, 5632, cx.G, cx.bid);
            pg8::EpiSwiGLU E{BIG, ssqb + (size_t)(l * 4 + (f ? 3 : 0)) * T * 4}; pg8::gemm_phase<pg8::EpiSwiGLU, pg8::StaticOrder>(cx.lds, g, S, E);
        }
        if (EN(OP_FFN_OUT) && (op == OP_FFN_OUT || op == OP_RWKV_OUT || op == OP_XO || op == OP_G3)) {
            const bf16_t* A; const bf16_t* Bt; int K; float alpha = 1.0f; int so;
            if (op == OP_FFN_OUT) { A = BIG; Bt = (const bf16_t*)(ws + OFF_WOUT + (size_t)(l * 2 + f) * SZ_WOUT); K = FF; alpha = 0.5f; so = l * 4 + (f ? 4 : 1); }
            else if (op == OP_RWKV_OUT) { A = (const bf16_t*)(ws + OFF_BIG + BIG_Y); Bt = (const bf16_t*)(ws + OFF_RWO); K = 1024; so = 2; }
            else if (op == OP_XO) { A = (const bf16_t*)(ws + OFF_BIG + BIG_O); Bt = (const bf16_t*)(ws + OFF_WO + (size_t)l * SZ_SQ); K = 1024; so = l * 4 + 3; }
            else { A = BIG; Bt = (const bf16_t*)(ws + OFF_GWO); K = 2048; so = 6; }
            pg8::Gemm g{A, Bt, T, 1024, K, K, K, 0, nullptr, nullptr}; pg8::StaticOrder S; S.init(T, 1024, cx.G, cx.bid);
            pg8::EpiResid E{XB, ssqb + (size_t)so * T * 4, alpha, cx.lds}; pg8::gemm_phase<pg8::EpiResid, pg8::StaticOrder>(cx.lds, g, S, E);
        }
        if (EN(OP_HN) && op == OP_HN) phase_hn(cx, p, ws);
        if (EN(OP_LORA) && op == OP_LORA) {
            pg8::Gemm g{(const bf16_t*)(ws + OFF_BIG), (const bf16_t*)(ws + OFF_WLO), T, NLO, 2048, 1024, 2048, (size_t)1024 * 2, nullptr, nullptr}; pg8::StaticOrder S; S.init(T, NLO, cx.G, cx.bid);
            pg8::EpiB<2> E{(bf16_t*)(ws + OFF_BIG + BIG_L), NLO, 0, 0, nullptr, nullptr, nullptr}; pg8::gemm_phase<pg8::EpiB<2>, pg8::StaticOrder>(cx.lds, g, S, E);
        }
        if (EN(OP_PREMIX) && op == OP_PREMIX) phase_premix(cx, p, ws);
        if (EN(OP_RWKV_PROJ) && op == OP_RWKV_PROJ) {
            const bf16_t* xr = (const bf16_t*)p->out;
            pg8::Gemm g{xr, (const bf16_t*)(ws + OFF_WRK), T, NRK, 1024, 1024, 1024, 0, xr + (size_t)T * C, (const bf16_t*)(ws + OFF_BIG + BIG_Y)}; pg8::StaticOrder S; S.init(T, NRK, cx.G, cx.bid);
            pg8::EpiB<0> E{BIG, NRK, 0, 0, nullptr, nullptr, nullptr}; pg8::gemm_phase<pg8::EpiB<0>, pg8::StaticOrder>(cx.lds, g, S, E);
        }
        if (EN(OP_SCAN) && op == OP_SCAN) phase_scan(cx, p, ws);
        if (EN(OP_POST) && op == OP_POST) phase_post(cx, p, ws);
        if (EN(OP_XQ) && op == OP_XQ) {
            pg8::Gemm g{XB, (const bf16_t*)(ws + OFF_WQ + (size_t)l * SZ_SQ), T, 1024, 1024, 1024, 1024, 0, nullptr, nullptr}; pg8::StaticOrder S; S.init(T, 1024, cx.G, cx.bid);
            pg8::EpiB<1> E{BIG, 1024, 0, 0, ssqb + (size_t)(l * 4 + 2) * T * 4, nullptr, nullptr}; pg8::gemm_phase<pg8::EpiB<1>, pg8::StaticOrder>(cx.lds, g, S, E);
        }
        if (EN(OP_XATT) && op == OP_XATT) phase_xattn(cx, p, ws);
        if (EN(OP_G1) && op == OP_G1) {
            pg8::Gemm g{XB, (const bf16_t*)(ws + OFF_GUV), T, 4096, 1024, 1024, 1024, 0, nullptr, nullptr}; pg8::StaticOrder S; S.init(T, 4096, cx.G, cx.bid);
            pg8::EpiB<3> E{BIG, 2048, 0, 0, ssqb + (size_t)5 * T * 4, (float*)(ws + OFF_SSQV), (bf16_t*)(ws + OFF_BIG + BIG_V)}; pg8::gemm_phase<pg8::EpiB<3>, pg8::StaticOrder>(cx.lds, g, S, E);
        }
        if (EN(OP_SPATIAL) && op == OP_SPATIAL) phase_spatial(cx, p, ws);
        if (EN(OP_FINAL) && op == OP_FINAL) phase_final(cx, p, ws);
        if (ph + 1 < p_.ph_hi) { if (p_.ph_hi > 1000) grid.sync(); else { XcdBarrier xb2 = xbar; asm volatile("" : "+s"(xb2.bar)); xcd_barrier(xb2); } }
        if (ph == REP_PH && rep < REP_N) { ++rep; --ph; }
    }
}

extern "C" void kernel_launch(void* const* d_in, const int* in_sizes, int n_in, void* d_out, int out_size, void* d_ws, size_t ws_size, hipStream_t stream) {
    static int grid = 0;
    if (grid == 0) {
        if (n_in != 36 || ws_size < WS_END) { fprintf(stderr, "kernel_launch: expected 36 inputs and >= %zu bytes of workspace (got %d, %zu)\n", (size_t)WS_END, n_in, ws_size); grid = -1; return; }
        int dev = 0, cus = 0, per_cu = 0;
        hipGetDevice(&dev); hipDeviceGetAttribute(&cus, hipDeviceAttributeMultiprocessorCount, dev);
        if (hipFuncSetAttribute((const void*)fwd_kernel, hipFuncAttributeMaxDynamicSharedMemorySize, LDS_BYTES) != hipSuccess) { fprintf(stderr, "kernel_launch: hipFuncSetAttribute failed\n"); grid = -1; return; }
        if (hipOccupancyMaxActiveBlocksPerMultiprocessor(&per_cu, (const void*)fwd_kernel, 512, LDS_BYTES) != hipSuccess || per_cu < 1) { fprintf(stderr, "kernel_launch: occupancy query says %d\n", per_cu); per_cu = 1; }
        (void)hipGetLastError();
        grid = cus * 1;
    }
    if (grid < 0) return;
    Params p{};
    for (int i = 0; i < 36; ++i) p.in[i] = (const float*)d_in[i];
    p.out = (float*)d_out; p.ws = (unsigned char*)d_ws;
#if MEGA
    (void)hipMemsetAsync((unsigned char*)d_ws + OFF_BAR, 0, 16384, stream);
    p.ph_lo = 0; p.ph_hi = NPHASE;
    void* args[] = {&p};
    hipError_t e = hipLaunchCooperativeKernel((const void*)fwd_kernel, dim3(grid), dim3(512), args, LDS_BYTES, stream);
    if (e != hipSuccess) fprintf(stderr, "cooperative launch failed: %s (grid %d)\n", hipGetErrorString(e), grid);
#else
    for (int ph = 0; ph < NPHASE; ++ph) { p.ph_lo = ph; p.ph_hi = ph + 1; hipLaunchKernelGGL(fwd_kernel, dim3(grid), dim3(512), LDS_BYTES, stream, p); }
#endif
}
```

```cpp
#include <hip/hip_runtime.h>
#include <hip/hip_cooperative_groups.h>
#include <cstdio>
namespace cg = cooperative_groups;

#ifndef MEGA
#define MEGA 1
#endif
#ifndef PHMASK
#define PHMASK 0xFFFFF
#endif
#define EN(x) ((PHMASK >> (x)) & 1)
#ifndef REP_PH
#define REP_PH -1
#define REP_N 0
#endif

#define LAS __attribute__((address_space(3)))
typedef unsigned short bf16_t;
typedef short bf16x8 __attribute__((ext_vector_type(8)));
typedef float f32x4 __attribute__((ext_vector_type(4)));
typedef float f32x2 __attribute__((ext_vector_type(2)));
typedef unsigned u32x4 __attribute__((ext_vector_type(4)));
typedef unsigned u32x2 __attribute__((ext_vector_type(2)));

constexpr int T = 32768, C = 1024, FF = 2816, SEQ = 4096, NB = 8;
constexpr int NRK = 3072;
constexpr int NLO = 512;
constexpr int LDS_TAB = 131072;
constexpr int LDS_PF = 135168;
constexpr int LDS_BAR = 163824;
constexpr int LDS_BYTES = LDS_BAR + 16;
constexpr float RMS_EPS = 1e-6f;

constexpr size_t SZ_WIN = (size_t)5632 * 1024 * 2, SZ_WOUT = (size_t)1024 * 2816 * 2, SZ_SQ = (size_t)1024 * 1024 * 2;
constexpr size_t OFF_WIN = 0;
constexpr size_t OFF_WOUT = OFF_WIN + 4 * SZ_WIN;
constexpr size_t OFF_WQ = OFF_WOUT + 4 * SZ_WOUT;
constexpr size_t OFF_WO = OFF_WQ + 2 * SZ_SQ;
constexpr size_t OFF_WMK = OFF_WO + 2 * SZ_SQ;
constexpr size_t OFF_WMV = OFF_WMK + SZ_SQ;
constexpr size_t OFF_WRK = OFF_WMV + SZ_SQ;
constexpr size_t OFF_WLO = OFF_WRK + (size_t)NRK * 1024 * 2;
constexpr size_t OFF_W2T = OFF_WRK + (size_t)3584 * 2048 * 2;
constexpr size_t OFF_A2T = OFF_W2T + 1024 * 64 * 2;
constexpr size_t OFF_G2T = OFF_A2T + 1024 * 64 * 2;
constexpr size_t OFF_RWO = OFF_G2T + 1024 * 160 * 2;
constexpr size_t OFF_GUV = OFF_RWO + SZ_SQ;
constexpr size_t OFF_GWO = OFF_GUV + (size_t)4096 * 1024 * 2;
constexpr size_t OFF_WS16 = OFF_GWO + (size_t)1024 * 2048 * 2;
constexpr size_t OFF_SSQ = OFF_WS16 + 16 * 128 * 128 * 2;
constexpr size_t OFF_SSQV = OFF_SSQ + (size_t)9 * T * 4 * 4;
constexpr size_t OFF_BONUS = OFF_SSQV + (size_t)T * 32 * 4;
constexpr size_t OFF_GNST = OFF_BONUS + (size_t)T * 16 * 4;
constexpr size_t OFF_MEMN = OFF_GNST + (size_t)T * 16 * 2 * 8;
constexpr size_t OFF_MK = OFF_MEMN + (size_t)2048 * 1024 * 2;
constexpr size_t OFF_VT = OFF_MK + (size_t)2048 * 1024 * 2;
constexpr size_t OFF_XB = OFF_VT + (size_t)2048 * 1024 * 2;
constexpr size_t OFF_BIG = OFF_XB + (size_t)(NB * 4097) * 1024 * 2 + 4096;
constexpr size_t BIG_L = (size_t)T * NRK * 2;
constexpr size_t BIG_Y = (size_t)T * 3584 * 2;
constexpr size_t BIG_V = (size_t)T * 2048 * 2;
constexpr size_t BIG_O = (size_t)T * 1024 * 2;
constexpr size_t BIG_P = 2 * BIG_O;
constexpr size_t OFF_BAR = OFF_BIG + BIG_Y + (size_t)T * 1024 * 2 + 32768;
constexpr size_t WS_END = OFF_BAR + 16384;
static_assert(WS_END <= (size_t)536870912, "workspace");

struct Params { const float* in[36]; float* out; unsigned char* ws; int ph_lo, ph_hi; };
typedef const __attribute__((address_space(4))) Params* PP;

__device__ __forceinline__ unsigned cvt_pk_bf16(float lo, float hi) { unsigned r; asm("v_cvt_pk_bf16_f32 %0, %1, %2" : "=v"(r) : "v"(lo), "v"(hi)); return r; }
__device__ __forceinline__ float bf_lo(unsigned w) { return __uint_as_float(w << 16); }
__device__ __forceinline__ float bf_hi(unsigned w) { return __uint_as_float(w & 0xffff0000u); }
template <int CTRL> __device__ __forceinline__ float dppf(float x) { return __int_as_float(__builtin_amdgcn_update_dpp(__float_as_int(x), __float_as_int(x), CTRL, 0xf, 0xf, false)); }
__device__ __forceinline__ float allred8(float x) { x += dppf<0xB1>(x); x += dppf<0x4E>(x); x += dppf<0x141>(x); return x; }
__device__ __forceinline__ float allred16(float x) { x = allred8(x); x += dppf<0x140>(x); return x; }
__device__ __forceinline__ void fred16x4(float& a, float& b, float& c, float& d) {
#define DPP4(ctrl) "v_add_f32_dpp %0, %0, %0 " ctrl " row_mask:0xf bank_mask:0xf\n\tv_add_f32_dpp %1, %1, %1 " ctrl " row_mask:0xf bank_mask:0xf\n\tv_add_f32_dpp %2, %2, %2 " ctrl " row_mask:0xf bank_mask:0xf\n\tv_add_f32_dpp %3, %3, %3 " ctrl " row_mask:0xf bank_mask:0xf\n\t"
    asm("s_nop 1\n\t" DPP4("quad_perm:[1,0,3,2]") DPP4("quad_perm:[2,3,0,1]") DPP4("row_half_mirror") DPP4("row_mirror") : "+v"(a), "+v"(b), "+v"(c), "+v"(d));
#undef DPP4
}
__device__ __forceinline__ void fred16x2(float& a, float& b) {
#define DPP2(ctrl) "v_add_f32_dpp %0, %0, %0 " ctrl " row_mask:0xf bank_mask:0xf\n\tv_add_f32_dpp %1, %1, %1 " ctrl " row_mask:0xf bank_mask:0xf\n\t"
    asm("s_nop 1\n\t" DPP2("quad_perm:[1,0,3,2]") "s_nop 0\n\t" DPP2("quad_perm:[2,3,0,1]") "s_nop 0\n\t" DPP2("row_half_mirror") "s_nop 0\n\t" DPP2("row_mirror") : "+v"(a), "+v"(b));
#undef DPP2
}
__device__ __forceinline__ float treduce16(const float (&P)[16], int lane) {
    const bool h = lane & 8, g = lane & 4, f = lane & 2, e = lane & 1;
    float k1[8], s1[8], a[8];
#pragma unroll
    for (int j = 0; j < 8; ++j) { k1[j] = h ? P[8 + j] : P[j]; s1[j] = h ? P[j] : P[8 + j]; }
    asm("s_nop 1\n\tv_add_f32_dpp %0, %8, %16 row_mirror row_mask:0xf bank_mask:0xf\n\tv_add_f32_dpp %1, %9, %17 row_mirror row_mask:0xf bank_mask:0xf\n\tv_add_f32_dpp %2, %10, %18 row_mirror row_mask:0xf bank_mask:0xf\n\t"
        "v_add_f32_dpp %3, %11, %19 row_mirror row_mask:0xf bank_mask:0xf\n\tv_add_f32_dpp %4, %12, %20 row_mirror row_mask:0xf bank_mask:0xf\n\tv_add_f32_dpp %5, %13, %21 row_mirror row_mask:0xf bank_mask:0xf\n\t"
        "v_add_f32_dpp %6, %14, %22 row_mirror row_mask:0xf bank_mask:0xf\n\tv_add_f32_dpp %7, %15, %23 row_mirror row_mask:0xf bank_mask:0xf"
        : "=&v"(a[0]), "=&v"(a[1]), "=&v"(a[2]), "=&v"(a[3]), "=&v"(a[4]), "=&v"(a[5]), "=&v"(a[6]), "=&v"(a[7])
        : "v"(s1[0]), "v"(s1[1]), "v"(s1[2]), "v"(s1[3]), "v"(s1[4]), "v"(s1[5]), "v"(s1[6]), "v"(s1[7]), "v"(k1[0]), "v"(k1[1]), "v"(k1[2]), "v"(k1[3]), "v"(k1[4]), "v"(k1[5]), "v"(k1[6]), "v"(k1[7]));
    float k2[4], s2[4], b[4];
#pragma unroll
    for (int j = 0; j < 4; ++j) { k2[j] = g ? a[4 + j] : a[j]; s2[j] = g ? a[j] : a[4 + j]; }
    asm("s_nop 1\n\tv_add_f32_dpp %0, %4, %8 row_half_mirror row_mask:0xf bank_mask:0xf\n\tv_add_f32_dpp %1, %5, %9 row_half_mirror row_mask:0xf bank_mask:0xf\n\t"
        "v_add_f32_dpp %2, %6, %10 row_half_mirror row_mask:0xf bank_mask:0xf\n\tv_add_f32_dpp %3, %7, %11 row_half_mirror row_mask:0xf bank_mask:0xf"
        : "=&v"(b[0]), "=&v"(b[1]), "=&v"(b[2]), "=&v"(b[3]) : "v"(s2[0]), "v"(s2[1]), "v"(s2[2]), "v"(s2[3]), "v"(k2[0]), "v"(k2[1]), "v"(k2[2]), "v"(k2[3]));
    float k3[2], s3[2], c[2];
#pragma unroll
    for (int j = 0; j < 2; ++j) { k3[j] = f ? b[2 + j] : b[j]; s3[j] = f ? b[j] : b[2 + j]; }
    asm("s_nop 1\n\tv_add_f32_dpp %0, %2, %4 quad_perm:[3,2,1,0] row_mask:0xf bank_mask:0xf\n\tv_add_f32_dpp %1, %3, %5 quad_perm:[3,2,1,0] row_mask:0xf bank_mask:0xf"
        : "=&v"(c[0]), "=&v"(c[1]) : "v"(s3[0]), "v"(s3[1]), "v"(k3[0]), "v"(k3[1]));
    const float k4 = e ? c[1] : c[0], s4 = e ? c[0] : c[1]; float r;
    asm("s_nop 1\n\tv_add_f32_dpp %0, %1, %2 quad_perm:[1,0,3,2] row_mask:0xf bank_mask:0xf" : "=&v"(r) : "v"(s4), "v"(k4));
    return r;
}
__device__ __forceinline__ float fred16(float x) {
    asm("s_nop 1\n\tv_add_f32_dpp %0, %0, %0 quad_perm:[1,0,3,2] row_mask:0xf bank_mask:0xf\n\ts_nop 1\n\tv_add_f32_dpp %0, %0, %0 quad_perm:[2,3,0,1] row_mask:0xf bank_mask:0xf\n\t"
        "s_nop 1\n\tv_add_f32_dpp %0, %0, %0 row_half_mirror row_mask:0xf bank_mask:0xf\n\ts_nop 1\n\tv_add_f32_dpp %0, %0, %0 row_mirror row_mask:0xf bank_mask:0xf" : "+v"(x));
    return x; }
__device__ __forceinline__ float sigmoidf_(float x) { return __builtin_amdgcn_rcpf(1.0f + __expf(-x)); }
__device__ __forceinline__ float tanhf_(float x) { const float e = __expf(-2.0f * fabsf(x)); const float t = (1.0f - e) * __builtin_amdgcn_rcpf(1.0f + e); return x < 0.f ? -t : t; }
__device__ __forceinline__ float gelu_tanh(float x) { const float t = x * (-2.3022081981f - 0.1029432398f * (x * x)); return x * __builtin_amdgcn_rcpf(1.0f + __builtin_amdgcn_exp2f(t)); }
__device__ __forceinline__ float ssq4(const float* part) { const f32x4 a = *(const f32x4*)part; return (a[0] + a[1]) + (a[2] + a[3]); }
__device__ __forceinline__ float ssq16(const float* part) { const f32x4 a = *(const f32x4*)part, b = *(const f32x4*)(part + 4), c = *(const f32x4*)(part + 8), d = *(const f32x4*)(part + 12);
    return (((a[0] + a[1]) + (a[2] + a[3])) + ((b[0] + b[1]) + (b[2] + b[3]))) + (((c[0] + c[1]) + (c[2] + c[3])) + ((d[0] + d[1]) + (d[2] + d[3]))); }
#define LBAR() do { asm volatile("s_waitcnt lgkmcnt(0)" ::: "memory"); __builtin_amdgcn_s_barrier(); asm volatile("" ::: "memory"); } while (0)

namespace pg8 {
constexpr int BM = 256, BK = 64, HALF = 128, HTB = HALF * BK * 2, NXCD = 8, WGM = 8;
__host__ __device__ __forceinline__ int lds_byte(int r, int c) { const int st = (r >> 4) * 2 + (c >> 5), rr = r & 15, cc = c & 31, ob = rr * 64 + cc * 2; return st * 1024 + (ob ^ (((ob >> 9) & 1) << 5)); }
__host__ __device__ __forceinline__ void stage_rc(int b, int& R, int& Cc) { const int st = b / 1024, sb = b % 1024, swz = sb ^ (((sb >> 9) & 1) << 5); R = (st >> 1) * 16 + swz / 64; Cc = (st & 1) * 32 + (swz % 64) / 2; }
__host__ __device__ __forceinline__ int perm32(int rho) { const int n = rho >> 4, i = rho & 15; return 8 * (i >> 2) + 4 * n + (i & 3); }

struct Unit { int pm, pn; };
struct Gemm { const bf16_t* A; const bf16_t* Bt; int M, N, K, lda, ldb; size_t padA; const bf16_t* A1; const bf16_t* A2; };

struct StaticOrder {
    int nM, nN, nwg, G, c;
    __device__ void init(int M, int N, int G_, int c_) { nM = M / BM; nN = N / BM; nwg = nM * nN; G = G_; c = c_; }
    __device__ bool next(int i, Unit& u) const {
        const long L = (long)i * G + c; if (L >= nwg) return false;
        int wgid = (int)L; { const int q = nwg / NXCD, r = nwg % NXCD, xcd = wgid % NXCD, off = wgid / NXCD; wgid = (xcd < r ? xcd * (q + 1) : r * (q + 1) + (xcd - r) * q) + off; }
        const int nig = WGM * nN, gid = wgid / nig, fm = gid * WGM, gsz = (nM - fm) < WGM ? (nM - fm) : WGM;
        u.pm = fm + ((wgid % nig) % gsz); u.pn = (wgid % nig) / gsz; return true;
    }
};
struct SingleUnit { __device__ bool next(int i, Unit& u) const { u.pm = 0; u.pn = 0; return i == 0; } };

template <class Epi, class Sched>
__device__ __forceinline__ void gemm_phase(LAS unsigned char* lds, const Gemm g, const Sched& S, const Epi& E) {
    int tid_ = threadIdx.x; asm volatile("" : "+v"(tid_));
    const int tid = tid_, wid = __builtin_amdgcn_readfirstlane(tid >> 6), lane = tid & 63, wr = wid >> 2, wc = wid & 3, fr = lane & 15, fq = lane >> 4;
    const int K = g.K, nt = K / BK;
    unsigned voffA[2], voffB[2];
#pragma unroll
    for (int i = 0; i < 2; ++i) { int R, Cc; stage_rc(tid * 16 + i * 8192, R, Cc); const int Rb = Epi::PERM ? ((R & ~31) + perm32(R & 31)) : R;
        voffA[i] = (unsigned)(R * g.lda + Cc) * 2u; voffB[i] = (unsigned)(Rb * g.ldb + Cc) * 2u; }
    const size_t kstep = (size_t)(BK * 2);
    const size_t hstepA = (size_t)HALF * g.lda * 2, hstepB = (size_t)HALF * g.ldb * 2;
    const size_t tstepA = 2 * hstepA, tstepB = 2 * hstepB;
    const unsigned ldsw = (unsigned)wid * 1024u;
    const int aoff = lds_byte(wr * 64 + fr, fq * 8), boff = lds_byte(wc * 32 + fr, fq * 8);
#define PG8_SA(b, h) (((b) * 2 + (h)) * HTB)
#define PG8_SB(b, h) ((4 + (b) * 2 + (h)) * HTB)
#define PG8_STAGE(bufoff, gbase, voff) do { _Pragma("unroll") for (int _i = 0; _i < 2; ++_i) \
        __builtin_amdgcn_global_load_lds((const unsigned*)((const char*)(gbase) + (voff)[_i]), (LAS unsigned*)(lds + (bufoff) + ldsw + _i * 8192), 16, 0, 0); } while (0)
#define PG8_LDA(dst, b, h) do { _Pragma("unroll") for (int m = 0; m < 4; ++m) _Pragma("unroll") for (int k = 0; k < 2; ++k) dst[m][k] = *(const LAS bf16x8*)(lds + PG8_SA(b, h) + aoff + m * 2048 + k * 1024); } while (0)
#define PG8_LDB(dst, b, h) do { _Pragma("unroll") for (int n = 0; n < 2; ++n) _Pragma("unroll") for (int k = 0; k < 2; ++k) dst[n][k] = *(const LAS bf16x8*)(lds + PG8_SB(b, h) + boff + n * 2048 + k * 1024); } while (0)
#define PG8_MMA(ai, bj, At, Bt) do { __builtin_amdgcn_s_setprio(1); _Pragma("unroll") for (int m = 0; m < 4; ++m) _Pragma("unroll") for (int n = 0; n < 2; ++n) _Pragma("unroll") for (int k = 0; k < 2; ++k) \
        acc[ai][bj][m][n] = __builtin_amdgcn_mfma_f32_16x16x32_bf16(Bt[n][k], At[m][k], acc[ai][bj][m][n], 0, 0, 0); __builtin_amdgcn_s_setprio(0); } while (0)
#define PG8_WAIT_V(n) asm volatile("s_waitcnt vmcnt(" #n ")" ::: "memory")
#define PG8_WAIT_L(n) asm volatile("s_waitcnt lgkmcnt(" #n ")" ::: "memory")
#define PG8_BAR __builtin_amdgcn_s_barrier()
#define PG8_SCHED __builtin_amdgcn_sched_barrier(0)
#define PG8_APTR(u) ((const char*)((g.A1 && (u).pn >= 4) ? ((u).pn >= 8 ? g.A2 : g.A1) : g.A) + (size_t)(u).pm * tstepA + (size_t)((u).pm >> 4) * g.padA)
#define PG8_BPTR(u) ((const char*)g.Bt + (size_t)(u).pn * tstepB)
    Unit cur, nxt; int ui = 0;
    if (!S.next(0, cur)) return;
    f32x4 acc[2][2][4][2];
#pragma unroll
    for (int a = 0; a < 2; ++a)
#pragma unroll
        for (int b = 0; b < 2; ++b)
#pragma unroll
            for (int m = 0; m < 4; ++m)
#pragma unroll
                for (int n = 0; n < 2; ++n) acc[a][b][m][n] = (f32x4){0.f, 0.f, 0.f, 0.f};
    bf16x8 At[4][2], B0[2][2], B1[2][2];
    const char* cA = PG8_APTR(cur); const char* cB = PG8_BPTR(cur);
    PG8_STAGE(PG8_SB(0, 0), cB, voffB); PG8_STAGE(PG8_SA(0, 0), cA, voffA); PG8_STAGE(PG8_SB(0, 1), cB + hstepB, voffB); PG8_STAGE(PG8_SA(0, 1), cA + hstepA, voffA);
    if (wr == 1) PG8_BAR;
    PG8_WAIT_V(4); PG8_BAR;
    PG8_STAGE(PG8_SB(1, 0), cB + kstep, voffB); PG8_STAGE(PG8_SA(1, 0), cA + kstep, voffA); PG8_STAGE(PG8_SB(1, 1), cB + hstepB + kstep, voffB);
    PG8_WAIT_V(6); PG8_BAR;
    for (;;) {
        if constexpr (Epi::PREFETCH) E.prefetch(cur, wr, fr, fq, lds, wid);
        const bool has_next = S.next(ui + 1, nxt);
        const char* nA = has_next ? PG8_APTR(nxt) : cA; const char* nB = has_next ? PG8_BPTR(nxt) : cB;
        for (int t = 0; t < nt; t += 2) {
            const bool last = (t == nt - 2);
            const char* a1 = cA + (size_t)(t + 1) * kstep;
            const char* a2 = last ? nA : cA + (size_t)(t + 2) * kstep; const char* b2 = last ? nB : cB + (size_t)(t + 2) * kstep;
            const char* a3 = a2 + kstep; const char* b3 = b2 + kstep;
            PG8_LDB(B0, 0, 0); PG8_SCHED; PG8_LDA(At, 0, 0); PG8_STAGE(PG8_SA(1, 1), a1 + hstepA, voffA);
            PG8_WAIT_L(8); PG8_BAR; PG8_WAIT_L(0); PG8_MMA(0, 0, At, B0); PG8_BAR; PG8_SCHED;
            PG8_LDB(B1, 0, 1); PG8_STAGE(PG8_SB(0, 0), b2, voffB);
            PG8_BAR; PG8_WAIT_L(0); PG8_MMA(0, 1, At, B1); PG8_BAR;
            PG8_LDA(At, 0, 1); PG8_STAGE(PG8_SA(0, 0), a2, voffA);
            PG8_BAR; PG8_WAIT_L(0); PG8_MMA(1, 0, At, B0); PG8_BAR; PG8_SCHED;
            PG8_STAGE(PG8_SB(0, 1), b2 + hstepB, voffB);
            PG8_WAIT_V(6); PG8_BAR; PG8_MMA(1, 1, At, B1); PG8_BAR;
            PG8_LDB(B0, 1, 0); PG8_SCHED; PG8_LDA(At, 1, 0); PG8_STAGE(PG8_SA(0, 1), a2 + hstepA, voffA);
            PG8_WAIT_L(8); PG8_BAR; PG8_WAIT_L(0); PG8_MMA(0, 0, At, B0); PG8_BAR; PG8_SCHED;
            PG8_LDB(B1, 1, 1); PG8_STAGE(PG8_SB(1, 0), b3, voffB);
            PG8_BAR; PG8_WAIT_L(0); PG8_MMA(0, 1, At, B1); PG8_BAR;
            PG8_LDA(At, 1, 1); PG8_STAGE(PG8_SA(1, 0), a3, voffA);
            PG8_BAR; PG8_WAIT_L(0); PG8_MMA(1, 0, At, B0); PG8_BAR; PG8_SCHED;
            PG8_STAGE(PG8_SB(1, 1), b3 + hstepB, voffB);
            PG8_WAIT_V(6); PG8_BAR; PG8_MMA(1, 1, At, B1); PG8_BAR;
        }
        if constexpr (!Epi::AFTER_DRAIN) { E(acc, cur, wr, wc, fr, fq, lds, wid); }
        if (!has_next) break;
#pragma unroll
        for (int a = 0; a < 2; ++a)
#pragma unroll
            for (int b = 0; b < 2; ++b)
#pragma unroll
                for (int m = 0; m < 4; ++m)
#pragma unroll
                    for (int n = 0; n < 2; ++n) acc[a][b][m][n] = (f32x4){0.f, 0.f, 0.f, 0.f};
        cur = nxt; cA = nA; cB = nB; ++ui;
    }
    PG8_WAIT_V(0);
    if (wr == 0) PG8_BAR;
    PG8_BAR;
    if constexpr (Epi::AFTER_DRAIN) { E.fused(acc, cur, wr, wc, fr, fq, lds, wid, lane); }
#undef PG8_SA
#undef PG8_SB
#undef PG8_STAGE
#undef PG8_LDA
#undef PG8_LDB
#undef PG8_MMA
#undef PG8_WAIT_V
#undef PG8_WAIT_L
#undef PG8_BAR
#undef PG8_SCHED
#undef PG8_APTR
#undef PG8_BPTR
}

typedef f32x4 AccT[2][2][4][2];
__device__ __forceinline__ void lane_pf8(const float* ssq, int row0, int fq, LAS unsigned char* lds, int wid) {
    const int fr_ = row0 & 15; const float* bp = ssq + (size_t)(row0 - fr_) * 4 + (fr_ + 16 * fq); asm volatile("" : "+v"(bp));
#pragma unroll
    for (int g8 = 0; g8 < 8; ++g8) __builtin_amdgcn_global_load_lds((const unsigned*)(bp + ((g8 >> 2) * HALF + (g8 & 3) * 16) * 4), (LAS unsigned*)(lds + LDS_PF + wid * 2048 + g8 * 256), 4, 0, 0);
}
__device__ __forceinline__ void lane_rstd8(LAS unsigned char* lds, int wid, int lane, float invn, float (&rs)[8]) {
    const int fr_ = lane & 15;
#pragma unroll
    for (int g8 = 0; g8 < 8; ++g8) { const f32x4 t4 = *(const LAS f32x4*)(lds + LDS_PF + wid * 2048 + g8 * 256 + fr_ * 16); rs[g8] = rsqrtf(((t4[0] + t4[1]) + (t4[2] + t4[3])) * invn + RMS_EPS); }
}
struct EpiSwiGLU {
    static constexpr bool PERM = true, AFTER_DRAIN = false, PREFETCH = true;
    bf16_t* H; const float* ssq;
    __device__ __forceinline__ void prefetch(const Unit& u, int wr, int fr, int fq, LAS unsigned char* lds, int wid) const { lane_pf8(ssq, u.pm * BM + wr * 64 + fr, fq, lds, wid); }
    __device__ __forceinline__ void operator()(const AccT& acc, const Unit& u, int wr, int wc, int fr, int fq, LAS unsigned char* lds_, int wid_) const {
        const int row0 = u.pm * BM + wr * 64 + fr, col0 = u.pn * 128 + wc * 32 + 8 * fq;
        float rs8[8]; lane_rstd8(lds_, wid_, fr + 16 * fq, 1.0f / 1024.0f, rs8);
#pragma unroll
        for (int ai = 0; ai < 2; ++ai)
#pragma unroll
            for (int m = 0; m < 4; ++m) { const int row = row0 + ai * HALF + m * 16; const float rs = rs8[ai * 4 + m]; const float rs2 = rs * rs, nrl = -1.4426950409f * rs;
                f32x4 h4[2];
#pragma unroll
                for (int n = 0; n < 2; ++n) { const f32x4 g4 = acc[ai][0][m][n], u4 = acc[ai][1][m][n]; const f32x4 t4 = g4 * nrl; f32x4 e4, r4;
#pragma unroll
                    for (int e = 0; e < 4; ++e) e4[e] = __builtin_amdgcn_exp2f(t4[e]);
                    const f32x4 d4 = e4 + 1.0f;
#pragma unroll
                    for (int e = 0; e < 4; ++e) r4[e] = __builtin_amdgcn_rcpf(d4[e]);
                    h4[n] = (g4 * u4) * (r4 * rs2); }
                u32x4 w; w.x = cvt_pk_bf16(h4[0][0], h4[0][1]); w.y = cvt_pk_bf16(h4[0][2], h4[0][3]); w.z = cvt_pk_bf16(h4[1][0], h4[1][1]); w.w = cvt_pk_bf16(h4[1][2], h4[1][3]);
                __builtin_nontemporal_store(w, (u32x4*)(H + (size_t)row * FF + col0)); asm volatile("" ::: "memory"); }
    }
};
struct EpiResid {
    static constexpr bool PERM = true, AFTER_DRAIN = false, PREFETCH = false;
    bf16_t* xb; float* ssq; float alpha; LAS unsigned char* lds;
    __device__ __forceinline__ void prefetch(const Unit&, int, int, int, LAS unsigned char*, int) const {}
    __device__ __forceinline__ void operator()(const AccT& acc, const Unit& u, int wr, int wc, int fr, int fq, LAS unsigned char*, int) const {
        LAS float* tab = (LAS float*)(lds + LDS_TAB);
        const int row0 = u.pm * BM + wr * 64 + fr, col0 = u.pn * BM + wc * 32 + 8 * fq;
        u32x4 xv[2][2];
#define RES_LOAD(g8, buf) do { const size_t off_ = (size_t)(row0 + ((g8) >> 2) * HALF + ((g8) & 3) * 16) * C + col0; \
            buf[0] = *(const u32x4*)(xb + off_); buf[1] = *(const u32x4*)(xb + off_ + HALF); } while (0)
        RES_LOAD(0, xv[0]);
#pragma unroll
        for (int g8 = 0; g8 < 8; ++g8) { const int ai = g8 >> 2, m = g8 & 3;
            if (g8 + 1 < 8) RES_LOAD(g8 + 1, xv[(g8 + 1) & 1]);
            const int row = row0 + ai * HALF + m * 16; const size_t off = (size_t)row * C + col0; float s = 0.f;
#pragma unroll
            for (int bj = 0; bj < 2; ++bj) { const u32x4 xw = xv[g8 & 1][bj];
                const f32x4 r0 = (f32x4){bf_lo(xw.x), bf_hi(xw.x), bf_lo(xw.y), bf_hi(xw.y)} + alpha * acc[ai][bj][m][0];
                const f32x4 r1 = (f32x4){bf_lo(xw.z), bf_hi(xw.z), bf_lo(xw.w), bf_hi(xw.w)} + alpha * acc[ai][bj][m][1];
                u32x4 w; w.x = cvt_pk_bf16(r0[0], r0[1]); w.y = cvt_pk_bf16(r0[2], r0[3]); w.z = cvt_pk_bf16(r1[0], r1[1]); w.w = cvt_pk_bf16(r1[2], r1[3]);
                __builtin_nontemporal_store(w, (u32x4*)(xb + off + bj * HALF));
                s += ((r0[0] * r0[0] + r0[1] * r0[1]) + (r0[2] * r0[2] + r0[3] * r0[3])) + ((r1[0] * r1[0] + r1[1] * r1[1]) + (r1[2] * r1[2] + r1[3] * r1[3])); }
            s += __shfl_xor(s, 16); s += __shfl_xor(s, 32);
            if (fq == 0) tab[(ai * HALF + wr * 64 + m * 16 + fr) * 4 + wc] = s; asm volatile("" ::: "memory"); }
#undef RES_LOAD
        asm volatile("s_waitcnt lgkmcnt(0)" ::: "memory"); __builtin_amdgcn_s_barrier(); __builtin_amdgcn_s_barrier(); asm volatile("" ::: "memory");
        if (wr == 0) { const int r = wc * 64 + fq * 16 + fr; const f32x4 t = *(const LAS f32x4*)(tab + r * 4); ssq[(size_t)(u.pm * BM + r) * 4 + u.pn] = (t[0] + t[1]) + (t[2] + t[3]); }
    }
};
template <int MODE> struct EpiB {
    static constexpr bool PERM = true, AFTER_DRAIN = false, PREFETCH = (MODE == 1 || MODE == 3);
    bf16_t* O; int ldc; int row_base, col_base; const float* ssq; float* ssqv; bf16_t* O2;
    __device__ __forceinline__ void prefetch(const Unit& u, int wr, int fr, int fq, LAS unsigned char* lds, int wid) const { if (MODE == 1 || MODE == 3) lane_pf8(ssq, u.pm * BM + wr * 64 + fr, fq, lds, wid); }
    __device__ __forceinline__ void operator()(const AccT& acc, const Unit& u, int wr, int wc, int fr, int fq, LAS unsigned char* lds_, int wid_) const {
        const int row0 = u.pm * BM + wr * 64 + fr; const int colt = u.pn * BM + wc * 32 + 8 * fq;
        float rs8[8];
        if (MODE == 1 || MODE == 3) lane_rstd8(lds_, wid_, fr + 16 * fq, 1.0f / 1024.0f, rs8);
#pragma unroll
        for (int ai = 0; ai < 2; ++ai)
#pragma unroll
            for (int m = 0; m < 4; ++m) { const int row = row0 + ai * HALF + m * 16; float rs = 1.0f; float sq = 0.f;
                if (MODE == 1 || MODE == 3) rs = rs8[ai * 4 + m];
#pragma unroll
                for (int bj = 0; bj < 2; ++bj) { const int col = colt + bj * HALF; f32x4 v4[2];
#pragma unroll
                    for (int n = 0; n < 2; ++n) { f32x4 x4 = acc[ai][bj][m][n]; if (MODE == 1 || MODE == 3) x4 = x4 * rs;
                        if (MODE == 2) { if (col < 64) {
#pragma unroll
                                for (int e = 0; e < 4; ++e) x4[e] = tanhf_(x4[e]); }
                            else if (col >= 128 && col < 288) {
#pragma unroll
                                for (int e = 0; e < 4; ++e) x4[e] = sigmoidf_(x4[e]); } }
                        if (MODE == 3) {
                            const f32x4 t4 = x4 * ((x4 * x4) * (-0.1029432398f) + (-2.3022081981f)); f32x4 e4, r4;
#pragma unroll
                            for (int e = 0; e < 4; ++e) e4[e] = __builtin_amdgcn_exp2f(t4[e]);
                            const f32x4 d4 = e4 + 1.0f;
#pragma unroll
                            for (int e = 0; e < 4; ++e) r4[e] = __builtin_amdgcn_rcpf(d4[e]);
                            x4 = x4 * r4; if (u.pn >= 8) { const f32x4 q4 = x4 * x4; sq += (q4[0] + q4[1]) + (q4[2] + q4[3]); } }
                        v4[n] = x4; }
                    u32x4 w; w.x = cvt_pk_bf16(v4[0][0], v4[0][1]); w.y = cvt_pk_bf16(v4[0][2], v4[0][3]); w.z = cvt_pk_bf16(v4[1][0], v4[1][1]); w.w = cvt_pk_bf16(v4[1][2], v4[1][3]);
                    if (MODE == 3) { bf16_t* dst = (col < 2048) ? (O + (size_t)row * 2048 + col) : (O2 + (size_t)row * 2048 + (col - 2048)); __builtin_nontemporal_store(w, (u32x4*)dst); }
                    else __builtin_nontemporal_store(w, (u32x4*)(O + (size_t)(row_base + row) * ldc + col_base + col)); }
                if (MODE == 3) { if (u.pn >= 8) { sq += __shfl_xor(sq, 16); sq += __shfl_xor(sq, 32); if (fq == 0) ssqv[(size_t)row * 32 + (u.pn - 8) * 4 + wc] = sq; } } asm volatile("" ::: "memory"); }
    }
};
struct EpiSoftmax {
    static constexpr bool PERM = true, AFTER_DRAIN = true, PREFETCH = false;
    bf16_t* P;
    __device__ __forceinline__ void prefetch(const Unit&, int, int, int, LAS unsigned char*, int) const {}
    __device__ __forceinline__ void fused(AccT& acc, const Unit& u, int wr, int wc, int fr, int fq, LAS unsigned char* lds, int wid, int lane) const {
        LAS float* tab = (LAS float*)lds;
#pragma unroll
        for (int ai = 0; ai < 2; ++ai)
#pragma unroll
            for (int m = 0; m < 4; ++m) { float mx = -3.0e38f;
#pragma unroll
                for (int bj = 0; bj < 2; ++bj)
#pragma unroll
                    for (int n = 0; n < 2; ++n)
#pragma unroll
                        for (int e = 0; e < 4; ++e) mx = fmaxf(mx, acc[ai][bj][m][n][e]);
                mx = fmaxf(mx, __shfl_xor(mx, 16)); mx = fmaxf(mx, __shfl_xor(mx, 32));
                if (fq == 0) tab[(ai * HALF + wr * 64 + m * 16 + fr) * 4 + wc] = mx; }
        LBAR();
        float sums[2][4];
#pragma unroll
        for (int ai = 0; ai < 2; ++ai)
#pragma unroll
            for (int m = 0; m < 4; ++m) { const f32x4 t4 = *(const LAS f32x4*)(tab + (ai * HALF + wr * 64 + m * 16 + fr) * 4);
                const float mx = fmaxf(fmaxf(t4[0], t4[1]), fmaxf(t4[2], t4[3])); float s = 0.f;
#pragma unroll
                for (int bj = 0; bj < 2; ++bj)
#pragma unroll
                    for (int n = 0; n < 2; ++n)
#pragma unroll
                        for (int e = 0; e < 4; ++e) { const float pv = __expf(acc[ai][bj][m][n][e] - mx); acc[ai][bj][m][n][e] = pv; s += pv; }
                s += __shfl_xor(s, 16); s += __shfl_xor(s, 32); sums[ai][m] = s; asm volatile("" ::: "memory"); }
        LBAR();
#pragma unroll
        for (int ai = 0; ai < 2; ++ai)
#pragma unroll
            for (int m = 0; m < 4; ++m) if (fq == 0) tab[(ai * HALF + wr * 64 + m * 16 + fr) * 4 + wc] = sums[ai][m];
        LBAR();
#pragma unroll
        for (int ai = 0; ai < 2; ++ai)
#pragma unroll
            for (int m = 0; m < 4; ++m) { const int r = ai * HALF + wr * 64 + m * 16 + fr; const f32x4 t4 = *(const LAS f32x4*)(tab + r * 4);
                const float inv = 1.0f / ((t4[0] + t4[1]) + (t4[2] + t4[3]));
#pragma unroll
                for (int bj = 0; bj < 2; ++bj) { const f32x4 a = acc[ai][bj][m][0] * inv, b = acc[ai][bj][m][1] * inv;
                    u32x4 w; w.x = cvt_pk_bf16(a[0], a[1]); w.y = cvt_pk_bf16(a[2], a[3]); w.z = cvt_pk_bf16(b[0], b[1]); w.w = cvt_pk_bf16(b[2], b[3]);
                    *(u32x4*)(P + (size_t)r * 256 + bj * HALF + wc * 32 + 8 * fq) = w; } asm volatile("" ::: "memory"); }
        LBAR();
    }
};
}

struct Ctx { int tid, lane, wv, G, bid; LAS unsigned char* lds; };

struct TJob { const float* src; int lds_, K, N, c0; bf16_t* dst; int ldd, rowmap, drow0, dcol0; const float* g; const float* mu; int mode; float cs; };
__device__ __forceinline__ void run_tconv(const Ctx& cx, const TJob& j) {
    LAS float* tile0 = (LAS float*)cx.lds;
    const int tk = (j.K + 63) >> 6, tn = (j.N + 63) >> 6, ntile = tk * tn;
    const int kr = cx.tid >> 3, nc = (cx.tid & 7) * 8;
    f32x4 la, lb; float sc = 0.f;
#define TC_LOAD(t_) do { const int k_ = ((t_) % tk) * 64 + kr, n_ = ((t_) / tk) * 64 + nc; la = (f32x4){0.f, 0.f, 0.f, 0.f}; lb = la; sc = 0.f; \
        if (k_ < j.K && n_ < j.N) { const float* sp_ = j.src + (size_t)k_ * j.lds_ + j.c0 + n_; la = *(const f32x4*)sp_; lb = *(const f32x4*)(sp_ + 4); \
            sc = j.cs; if (j.g) sc *= j.g[k_]; if (j.mode == 1) sc *= j.mu[k_]; else if (j.mode == 2) sc *= (1.0f - j.mu[k_]); } } while (0)
    int t = cx.bid, it = 0;
    if (t < ntile) TC_LOAD(t);
    for (; t < ntile; t += cx.G, ++it) {
        LAS float* tile = tile0 + (it & 1) * (64 * 65);
        const int k0 = (t % tk) * 64, n0 = (t / tk) * 64;
        { const f32x4 a = la * sc, b = lb * sc;
#pragma unroll
            for (int e = 0; e < 4; ++e) { tile[kr * 65 + nc + e] = a[e]; tile[kr * 65 + nc + 4 + e] = b[e]; } }
        if (t + cx.G < ntile) TC_LOAD(t + cx.G);
        __syncthreads();
        { const int nr = cx.tid >> 3, kc = (cx.tid & 7) * 8; const int n = n0 + nr, k = k0 + kc;
            if (n < j.N && k < j.K) { float v[8];
#pragma unroll
                for (int e = 0; e < 8; ++e) v[e] = tile[(kc + e) * 65 + nr];
                const int drow = j.drow0 + (j.rowmap ? ((n >> 7) * 256 + (n & 127)) : n);
                u32x4 w; w.x = cvt_pk_bf16(v[0], v[1]); w.y = cvt_pk_bf16(v[2], v[3]); w.z = cvt_pk_bf16(v[4], v[5]); w.w = cvt_pk_bf16(v[6], v[7]);
                __builtin_nontemporal_store(w, (u32x4*)(j.dst + (size_t)drow * j.ldd + j.dcol0 + k)); } }
    }
    __syncthreads();
#undef TC_LOAD
}
__device__ __forceinline__ bool make_job(int i, PP p, unsigned char* ws, TJob& j) {
    j.g = nullptr; j.mu = nullptr; j.mode = 0; j.cs = 1.0f; j.rowmap = 0; j.drow0 = 0; j.dcol0 = 0; j.c0 = 0;
    if (i < 8) {
        const int bj = i & 1, f = (i >> 1) & 1, l = i >> 2;
        j.src = p->in[f ? 12 : 5] + (size_t)l * 1024 * 5632; j.lds_ = 5632; j.K = 1024; j.N = 2816; j.c0 = bj * 2816;
        j.dst = (bf16_t*)(ws + OFF_WIN + (size_t)(l * 2 + f) * SZ_WIN); j.ldd = 1024; j.rowmap = 1; j.drow0 = bj * 128; j.g = p->in[f ? 11 : 4] + l * 1024; return true; }
    i -= 8;
    if (i < 4) {
        const int f = i & 1, l = i >> 1;
        j.src = p->in[f ? 13 : 6] + (size_t)l * 2816 * 1024; j.lds_ = 1024; j.K = 2816; j.N = 1024; j.dst = (bf16_t*)(ws + OFF_WOUT + (size_t)(l * 2 + f) * SZ_WOUT); j.ldd = 2816; return true; }
    i -= 4;
    if (i < 4) {
        const int o = i & 1, l = i >> 1;
        j.src = p->in[o ? 10 : 9] + (size_t)l * 1024 * 1024; j.lds_ = 1024; j.K = 1024; j.N = 1024; j.dst = (bf16_t*)(ws + (o ? OFF_WO : OFF_WQ) + (size_t)l * SZ_SQ); j.ldd = 1024;
        if (!o) { j.g = p->in[8] + l * 1024; j.cs = 0.0625f; } return true; }
    i -= 4;
    if (i < 2) {
        j.src = p->in[3]; j.lds_ = 2048; j.K = 1024; j.N = 1024; j.c0 = i * 1024; j.dst = (bf16_t*)(ws + (i ? OFF_WMV : OFF_WMK)); j.ldd = 1024; j.g = p->in[2]; return true; }
    i -= 2;
    if (i < 3) {
        j.src = p->in[15]; j.lds_ = 3072; j.K = 1024; j.N = 1024; j.c0 = i * 1024; j.drow0 = i * 1024; j.dst = (bf16_t*)(ws + OFF_WRK); j.ldd = 1024; j.g = p->in[7]; return true; }
    i -= 3;
    if (i < 6) {
        const int half = i & 1, part = i >> 1;
        if (part == 0) { j.src = p->in[17]; j.lds_ = 64; j.N = 64; j.drow0 = 0; }
        else if (part == 1) { j.src = p->in[20]; j.lds_ = 64; j.N = 64; j.drow0 = 64; }
        else { j.src = p->in[22]; j.lds_ = 160; j.N = 160; j.drow0 = 128; }
        const int mi = part == 0 ? 1 : part == 1 ? 4 : 5;
        j.K = 1024; j.dst = (bf16_t*)(ws + OFF_WLO); j.ldd = 2048; j.dcol0 = half ? 1024 : 0; j.g = p->in[7]; j.mu = p->in[14] + mi * 1024; j.mode = half ? 2 : 1; return true; }
    i -= 6;
    if (i == 0) { j.src = p->in[18]; j.lds_ = 1024; j.K = 64; j.N = 1024; j.dst = (bf16_t*)(ws + OFF_W2T); j.ldd = 64; return true; }
    if (i == 1) { j.src = p->in[21]; j.lds_ = 1024; j.K = 64; j.N = 1024; j.dst = (bf16_t*)(ws + OFF_A2T); j.ldd = 64; return true; }
    if (i == 2) { j.src = p->in[23]; j.lds_ = 1024; j.K = 160; j.N = 1024; j.dst = (bf16_t*)(ws + OFF_G2T); j.ldd = 160; return true; }
    if (i == 3) { j.src = p->in[29]; j.lds_ = 1024; j.K = 1024; j.N = 1024; j.dst = (bf16_t*)(ws + OFF_RWO); j.ldd = 1024; return true; }
    if (i == 4) { j.src = p->in[30]; j.lds_ = 4096; j.K = 1024; j.N = 4096; j.dst = (bf16_t*)(ws + OFF_GUV); j.ldd = 1024; j.g = p->in[7] + 1024; return true; }
    if (i == 5) { j.src = p->in[34]; j.lds_ = 1024; j.K = 2048; j.N = 1024; j.dst = (bf16_t*)(ws + OFF_GWO); j.ldd = 2048; return true; }
    return false;
}

__device__ __forceinline__ bool is_late_job(int i) { return (i >= 2 && i < 8) || (i >= 9 && i < 16) || (i >= 30 && i < 33); }
constexpr int LATE_TILES = 73216;
__device__ __forceinline__ void conv_tile8(PP p, unsigned char* ws, int t, int lane) {
    int q, local;
    if (t < 33792) { q = t / 5632; local = t - q * 5632; }
    else if (t < 50688) { const int u = t - 33792; q = u / 5632; local = u - q * 5632; q += 6; }
    else if (t < 58880) { const int u = t - 50688; q = u >> 11; local = u & 2047; q += 9; }
    else if (t < 60928) { q = 13; local = t - 58880; }
    else if (t < 69120) { q = 14; local = t - 60928; }
    else { q = 15; local = t - 69120; }
    TJob j; (void)make_job(q < 6 ? q + 2 : (q < 13 ? q + 3 : q + 17), p, ws, j);
    const int kb = j.K >> 3, nt_ = local / kb, kt = local - nt_ * kb, k0 = kt * 8, n = nt_ * 64 + lane;
    const float* sp = j.src + (size_t)k0 * j.lds_ + j.c0 + n; float v[8];
#pragma unroll
    for (int e = 0; e < 8; ++e) v[e] = sp[(size_t)e * j.lds_];
#pragma unroll
    for (int e = 0; e < 8; ++e) v[e] *= j.g ? j.cs * j.g[k0 + e] : j.cs;
    const int drow = j.drow0 + (j.rowmap ? ((n >> 7) * 256 + (n & 127)) : n);
    u32x4 w; w.x = cvt_pk_bf16(v[0], v[1]); w.y = cvt_pk_bf16(v[2], v[3]); w.z = cvt_pk_bf16(v[4], v[5]); w.w = cvt_pk_bf16(v[6], v[7]);
    *(u32x4*)(j.dst + (size_t)drow * j.ldd + j.dcol0 + k0) = w;
}

__device__ __forceinline__ void phase_prep(const Ctx& cx, PP p, unsigned char* ws) {
    { const float* w = p->in[32]; bf16_t* o = (bf16_t*)(ws + OFF_WS16); for (int i = cx.bid * 512 + cx.tid; i < 16 * 128 * 128; i += cx.G * 512) { const int s = i & 127, t = (i >> 7) & 127; o[i] = (bf16_t)(cvt_pk_bf16(s <= t ? w[i] : 0.f, 0.f) & 0xffffu); } }
    const int gw = cx.bid * 8 + cx.wv, nw = cx.G * 8;
    { const float* x = p->in[0]; bf16_t* xb = (bf16_t*)(ws + OFF_XB); float* ssq0 = (float*)(ws + OFF_SSQ);
        for (int r = gw; r < T; r += nw) { float s = 0.f;
#pragma unroll
            for (int i = 0; i < 4; ++i) { const size_t o = (size_t)r * C + i * 256 + cx.lane * 4; const f32x4 v = *(const f32x4*)(x + o);
                u32x2 w; w.x = cvt_pk_bf16(v[0], v[1]); w.y = cvt_pk_bf16(v[2], v[3]); *(u32x2*)(xb + o) = w; s += (v[0] * v[0] + v[1] * v[1]) + (v[2] * v[2] + v[3] * v[3]); }
#pragma unroll
            for (int o = 32; o >= 1; o >>= 1) s += __shfl_xor(s, o);
            if (cx.lane < 4) ssq0[(size_t)r * 4 + cx.lane] = cx.lane == 0 ? s : 0.f; } }
    { const float* x = p->in[1]; bf16_t* xb = (bf16_t*)(ws + OFF_MEMN);
        for (int r = gw; r < 2048; r += nw) { float s = 0.f; f32x4 v[4];
#pragma unroll
            for (int i = 0; i < 4; ++i) { v[i] = *(const f32x4*)(x + (size_t)r * C + i * 256 + cx.lane * 4); s += (v[i][0] * v[i][0] + v[i][1] * v[i][1]) + (v[i][2] * v[i][2] + v[i][3] * v[i][3]); }
#pragma unroll
            for (int o = 32; o >= 1; o >>= 1) s += __shfl_xor(s, o);
            const float rs = rsqrtf(s * (1.0f / 1024.0f) + RMS_EPS);
#pragma unroll
            for (int i = 0; i < 4; ++i) { u32x2 w; w.x = cvt_pk_bf16(v[i][0] * rs, v[i][1] * rs); w.y = cvt_pk_bf16(v[i][2] * rs, v[i][3] * rs); *(u32x2*)(xb + (size_t)r * C + i * 256 + cx.lane * 4) = w; } } }
    for (int i = 0;; ++i) { TJob j; if (!make_job(i, p, ws, j)) break; if (is_late_job(i)) continue; run_tconv(cx, j); }
}
__device__ __forceinline__ void phase_hn(const Ctx& cx, PP p, unsigned char* ws) {
    const bf16_t* x = (const bf16_t*)(ws + OFF_XB); bf16_t* hn = (bf16_t*)(ws + OFF_BIG + BIG_Y); const float* ssq = (const float*)(ws + OFF_SSQ) + (size_t)1 * T * 4;
    const int gw = cx.bid * 8 + cx.wv, nw = cx.G * 8;
    for (int r = gw; r < T; r += nw) { const int b = r >> 12, s = r & 4095; const float rs = rsqrtf(ssq4(ssq + (size_t)r * 4) * (1.0f / 1024.0f) + RMS_EPS);
        bf16_t* dst = hn + (size_t)(b * 4097 + 1 + s) * C;
#pragma unroll
        for (int i = 0; i < 2; ++i) { const int c = i * 512 + cx.lane * 8; const u32x4 v = *(const u32x4*)(x + (size_t)r * C + c);
            u32x4 w; w.x = cvt_pk_bf16(bf_lo(v.x) * rs, bf_hi(v.x) * rs); w.y = cvt_pk_bf16(bf_lo(v.y) * rs, bf_hi(v.y) * rs); w.z = cvt_pk_bf16(bf_lo(v.z) * rs, bf_hi(v.z) * rs); w.w = cvt_pk_bf16(bf_lo(v.w) * rs, bf_hi(v.w) * rs);
            __builtin_nontemporal_store(w, (u32x4*)(dst + c));
            if (s == 0) { u32x4 z; z.x = 0u; z.y = 0u; z.z = 0u; z.w = 0u; *(u32x4*)(dst - C + c) = z; } } }
}
__device__ __forceinline__ void phase_premix(const Ctx& cx, PP p, unsigned char* ws) {
    const bf16_t* x = (const bf16_t*)(ws + OFF_XB); const float* ssq = (const float*)(ws + OFF_SSQ) + (size_t)1 * T * 4;
    bf16_t* xr = (bf16_t*)p->out; bf16_t* xk = xr + (size_t)T * C; bf16_t* xv = (bf16_t*)(ws + OFF_BIG + BIG_Y);
    bf16_t* hn = (bf16_t*)(ws + OFF_BIG);
    const float* mur = p->in[14]; const float* muk = mur + 2 * 1024; const float* muv = mur + 3 * 1024;
    const int gw = cx.bid * 8 + cx.wv, nw = cx.G * 8;
    for (int r = gw; r < T; r += nw) { const int s_ = r & 4095; const float rs = rsqrtf(ssq4(ssq + (size_t)r * 4) * (1.0f / 1024.0f) + RMS_EPS);
        const float rp = s_ ? rsqrtf(ssq4(ssq + (size_t)(r - 1) * 4) * (1.0f / 1024.0f) + RMS_EPS) : 0.f; const size_t rprev = s_ ? (size_t)(r - 1) : (size_t)r;
#pragma unroll
        for (int i = 0; i < 2; ++i) { const int c = i * 512 + cx.lane * 8; const u32x4 vc = *(const u32x4*)(x + (size_t)r * C + c), vp = *(const u32x4*)(x + rprev * C + c);
            float h[8], d[8];
#pragma unroll
            for (int e = 0; e < 4; ++e) { h[2 * e] = bf_lo(vc[e]) * rs; h[2 * e + 1] = bf_hi(vc[e]) * rs; d[2 * e] = bf_lo(vp[e]) * rp - h[2 * e]; d[2 * e + 1] = bf_hi(vp[e]) * rp - h[2 * e + 1]; }
            { u32x4 wh; wh.x = cvt_pk_bf16(h[0], h[1]); wh.y = cvt_pk_bf16(h[2], h[3]); wh.z = cvt_pk_bf16(h[4], h[5]); wh.w = cvt_pk_bf16(h[6], h[7]);
                bf16_t* dsth = hn + (size_t)((r >> 12) * 4097 + 1 + s_) * C + c; __builtin_nontemporal_store(wh, (u32x4*)dsth);
                if (s_ == 0) { unsigned zz = 0u; asm volatile("" : "+v"(zz)); u32x4 z; z.x = zz; z.y = zz; z.z = zz; z.w = zz; *(u32x4*)(dsth - C) = z; } }
            const f32x4 a0 = *(const f32x4*)(mur + c), a1 = *(const f32x4*)(mur + c + 4), b0 = *(const f32x4*)(muk + c), b1 = *(const f32x4*)(muk + c + 4), c0 = *(const f32x4*)(muv + c), c1 = *(const f32x4*)(muv + c + 4);
            u32x4 wr_, wk_, wv_;
#pragma unroll
            for (int e = 0; e < 4; ++e) { const float m0r = e < 2 ? a0[2 * e] : a1[2 * e - 4], m1r = e < 2 ? a0[2 * e + 1] : a1[2 * e - 3], m0k = e < 2 ? b0[2 * e] : b1[2 * e - 4], m1k = e < 2 ? b0[2 * e + 1] : b1[2 * e - 3];
                const float m0v = e < 2 ? c0[2 * e] : c1[2 * e - 4], m1v = e < 2 ? c0[2 * e + 1] : c1[2 * e - 3];
                wr_[e] = cvt_pk_bf16(h[2 * e] + d[2 * e] * m0r, h[2 * e + 1] + d[2 * e + 1] * m1r); wk_[e] = cvt_pk_bf16(h[2 * e] + d[2 * e] * m0k, h[2 * e + 1] + d[2 * e + 1] * m1k);
                wv_[e] = cvt_pk_bf16(h[2 * e] + d[2 * e] * m0v, h[2 * e + 1] + d[2 * e + 1] * m1v); }
            __builtin_nontemporal_store(wr_, (u32x4*)(xr + (size_t)r * C + c)); __builtin_nontemporal_store(wk_, (u32x4*)(xk + (size_t)r * C + c)); __builtin_nontemporal_store(wv_, (u32x4*)(xv + (size_t)r * C + c)); } }
}
__device__ __forceinline__ void phase_final(const Ctx& cx, PP p, unsigned char* ws) {
    const bf16_t* x = (const bf16_t*)(ws + OFF_XB); float* out = p->out; const float* ssq = (const float*)(ws + OFF_SSQ) + (size_t)8 * T * 4; const float* gf = p->in[35];
    const int gw = cx.bid * 8 + cx.wv, nw = cx.G * 8;
    for (int r = gw; r < T; r += nw) { const float rs = rsqrtf(ssq4(ssq + (size_t)r * 4) * (1.0f / 1024.0f) + RMS_EPS);
#pragma unroll
        for (int i = 0; i < 2; ++i) { const int c = i * 512 + cx.lane * 8; const u32x4 v = *(const u32x4*)(x + (size_t)r * C + c); const f32x4 g0 = *(const f32x4*)(gf + c), g1 = *(const f32x4*)(gf + c + 4);
            const f32x4 o0 = (f32x4){bf_lo(v.x), bf_hi(v.x), bf_lo(v.y), bf_hi(v.y)} * rs * g0, o1 = (f32x4){bf_lo(v.z), bf_hi(v.z), bf_lo(v.w), bf_hi(v.w)} * rs * g1;
            __builtin_nontemporal_store(o0, (f32x4*)(out + (size_t)r * C + c)); __builtin_nontemporal_store(o1, (f32x4*)(out + (size_t)r * C + c + 4)); } }
}

constexpr int SC_BUF = 6 * 2048;
constexpr int SC_Y = 2 * SC_BUF;
constexpr int SC_W2 = (SC_Y + 2048) * 4;
constexpr int SC_A2 = SC_W2 + 64 * 144, SC_G2 = SC_A2 + 64 * 144, SC_CONST = SC_G2 + 64 * 336, SC_END = SC_CONST + 5 * 256;
static_assert(SC_END <= LDS_BYTES, "scan LDS");
__device__ __forceinline__ void phase_scan(const Ctx& cx, PP p, unsigned char* ws) {
    const bf16_t* RK = (const bf16_t*)(ws + OFF_BIG); bf16_t* Y = (bf16_t*)(ws + OFF_BIG + BIG_Y); bf16_t* Gt = (bf16_t*)p->out;
    float* bonus = (float*)(ws + OFF_BONUS); f32x2* gnst = (f32x2*)(ws + OFF_GNST);
    const bf16_t* W2T = (const bf16_t*)(ws + OFF_W2T); const bf16_t* A2T = (const bf16_t*)(ws + OFF_A2T); const bf16_t* G2T = (const bf16_t*)(ws + OFF_G2T);
    LAS float* sF = (LAS float*)cx.lds; LAS float* sY = sF + SC_Y; LAS float* sC = (LAS float*)(cx.lds + SC_CONST);
    const int tid = cx.tid, lane = cx.lane, wv = cx.wv, fr = lane & 15, fq = lane >> 4;
    const int irow = (wv & 3) * 8 + (lane >> 4) * 2, seg = lane & 15;
    int wtile = cx.bid * 2 + (wv - 6);
    for (int unit = cx.bid; unit < 256; unit += cx.G) {
        const int chain = unit >> 1, half = unit & 1, b = chain >> 4, h = chain & 15, tok0 = b * SEQ;
        LBAR();
        for (int i = tid; i < 64 * 8; i += 512) { const int r = i >> 3, q = i & 7; *(LAS u32x4*)(cx.lds + SC_W2 + r * 144 + q * 16) = *(const u32x4*)(W2T + (size_t)(h * 64 + r) * 64 + q * 8);
            *(LAS u32x4*)(cx.lds + SC_A2 + r * 144 + q * 16) = *(const u32x4*)(A2T + (size_t)(h * 64 + r) * 64 + q * 8); }
        for (int i = tid; i < 64 * 20; i += 512) { const int r = i / 20, q = i % 20; *(LAS u32x4*)(cx.lds + SC_G2 + r * 336 + q * 16) = *(const u32x4*)(G2T + (size_t)(h * 64 + r) * 160 + q * 8); }
        if (tid < 320) { const int a = tid >> 6, c = tid & 63; const float* src = a == 0 ? p->in[16] : a == 1 ? p->in[19] : a == 2 ? p->in[24] : a == 3 ? p->in[25] : p->in[26]; sC[a * 64 + c] = src[h * 64 + c]; }
        LBAR();
        if (wv < 4) {
        f32x2 sA0 = (f32x2){0.f, 0.f}, sA1 = sA0, sB0 = sA0, sB1 = sA0;
            for (int c = -1; c < SEQ / 32 + 1; ++c) {
                if (c >= 0) LBAR();
                if (c >= 0 && c < SEQ / 32) {
                    __builtin_amdgcn_s_setprio(3);
                    LAS float* buf = sF + (c & 1) * SC_BUF; LAS float* yo = sY + (c & 1) * 1024;
                    const LAS float* bp = buf + seg * 4; const LAS float* vp = buf + 5 * 2048 + half * 32 + irow;
                    f32x4 cw = *(const LAS f32x4*)(bp), cq = *(const LAS f32x4*)(bp + 1 * 2048), cb = *(const LAS f32x4*)(bp + 2 * 2048), ck = *(const LAS f32x4*)(bp + 3 * 2048), cr = *(const LAS f32x4*)(bp + 4 * 2048);
                    f32x2 cv = *(const LAS f32x2*)(vp);
#pragma unroll 1
                    for (int hb = 0; hb < 2; ++hb) { float PA[16], PB[16];
#pragma unroll
                        for (int i = 0; i < 16; ++i) { const int tn = (hb * 16 + i + 1) & 31; const LAS float* np_ = bp + tn * 64;
                            const f32x4 nw = *(const LAS f32x4*)(np_), nq = *(const LAS f32x4*)(np_ + 1 * 2048), nb = *(const LAS f32x4*)(np_ + 2 * 2048), nk = *(const LAS f32x4*)(np_ + 3 * 2048), nr = *(const LAS f32x4*)(np_ + 4 * 2048);
                            const f32x2 nv = *(const LAS f32x2*)(vp + tn * 64);
                            const f32x2 q0 = (f32x2){cq[0], cq[1]}, q1 = (f32x2){cq[2], cq[3]}, w0 = (f32x2){cw[0], cw[1]}, w1 = (f32x2){cw[2], cw[3]}, b0 = (f32x2){cb[0], cb[1]}, b1 = (f32x2){cb[2], cb[3]};
                            const f32x2 k0 = (f32x2){ck[0], ck[1]}, k1 = (f32x2){ck[2], ck[3]}, r0 = (f32x2){cr[0], cr[1]}, r1 = (f32x2){cr[2], cr[3]};
                            f32x2 ta = sA0 * q0; ta += sA1 * q1; f32x2 tb = sB0 * q0; tb += sB1 * q1;
                            float saA = ta[0] + ta[1], saB = tb[0] + tb[1];
                            fred16x2(saA, saB);
                            const f32x2 vA = (f32x2){cv[0], cv[0]}, vB = (f32x2){cv[1], cv[1]}, nA = (f32x2){-saA, -saA}, nB = (f32x2){-saB, -saB};
                            sA0 = sA0 * w0 + vA * k0; sA1 = sA1 * w1 + vA * k1; sB0 = sB0 * w0 + vB * k0; sB1 = sB1 * w1 + vB * k1;
                            sA0 += nA * b0; sA1 += nA * b1; sB0 += nB * b0; sB1 += nB * b1;
                            f32x2 ya = sA0 * r0; ya += sA1 * r1; f32x2 yb = sB0 * r0; yb += sB1 * r1;
                            PA[i] = ya[0] + ya[1]; PB[i] = yb[0] + yb[1];
                            cw = nw; cq = nq; cb = nb; ck = nk; cr = nr; cv = nv; }
                        const float yA = treduce16(PA, lane), yB = treduce16(PB, lane);
                        *(LAS f32x2*)(yo + (hb * 16 + seg) * 32 + irow) = (f32x2){yA, yB}; }
                    __builtin_amdgcn_s_setprio(0); }
            }
        } else if (wv < 6) {
        bf16x8 aw[2], aa[2], ag[5]; u32x2 rr[4], kr[4], vr[4];
#define SC_PLOAD(cn_) do { const size_t tok_ = (size_t)(tok0 + (cn_) * 32 + (wv - 4) * 16 + fr); const bf16_t* lp_ = (const bf16_t*)(ws + OFF_BIG + BIG_L) + tok_ * NLO + fq * 8; const bf16_t* rp_ = RK + tok_ * NRK + h * 64 + fq * 4; \
            _Pragma("unroll") for (int ks = 0; ks < 2; ++ks) { aw[ks] = *(const bf16x8*)(lp_ + ks * 32); aa[ks] = *(const bf16x8*)(lp_ + 64 + ks * 32); } \
            _Pragma("unroll") for (int ks = 0; ks < 5; ++ks) ag[ks] = *(const bf16x8*)(lp_ + 128 + ks * 32); \
            _Pragma("unroll") for (int cb = 0; cb < 4; ++cb) { rr[cb] = *(const u32x2*)(rp_ + cb * 16); kr[cb] = *(const u32x2*)(rp_ + 1024 + cb * 16); vr[cb] = *(const u32x2*)(rp_ + 2048 + cb * 16); } } while (0)
            SC_PLOAD(0);
            for (int c = -1; c < SEQ / 32 + 1; ++c) {
                if (c >= 0) LBAR();
                const int cn = c + 1;
                if (cn < SEQ / 32) {
                    LAS float* buf = sF + (cn & 1) * SC_BUF; const int pw = wv - 4, tl = pw * 16 + fr; const size_t tok = (size_t)(tok0 + cn * 32 + tl);
                    float ssq = 0.f, bo = 0.f;
#pragma unroll
                    for (int cb = 0; cb < 4; ++cb) {
                        f32x4 cw = (f32x4){0.f, 0.f, 0.f, 0.f}, ca = cw, cgv = cw; const int brow = cb * 16 + fr;
#pragma unroll
                        for (int ks = 0; ks < 2; ++ks) { cw = __builtin_amdgcn_mfma_f32_16x16x32_bf16(*(const LAS bf16x8*)(cx.lds + SC_W2 + brow * 144 + ks * 64 + fq * 16), aw[ks], cw, 0, 0, 0);
                            ca = __builtin_amdgcn_mfma_f32_16x16x32_bf16(*(const LAS bf16x8*)(cx.lds + SC_A2 + brow * 144 + ks * 64 + fq * 16), aa[ks], ca, 0, 0, 0); }
#pragma unroll
                        for (int ks = 0; ks < 5; ++ks) cgv = __builtin_amdgcn_mfma_f32_16x16x32_bf16(*(const LAS bf16x8*)(cx.lds + SC_G2 + brow * 336 + ks * 64 + fq * 16), ag[ks], cgv, 0, 0, 0);
                        const int c0 = cb * 16 + fq * 4;
                        const f32x4 w04 = *(const LAS f32x4*)(sC + c0), a04 = *(const LAS f32x4*)(sC + 64 + c0), kk4 = *(const LAS f32x4*)(sC + 128 + c0), ka4 = *(const LAS f32x4*)(sC + 192 + c0), rk4 = *(const LAS f32x4*)(sC + 256 + c0);
                        f32x4 dec, a4;
#pragma unroll
                        for (int e = 0; e < 4; ++e) { dec[e] = __expf(-0.6065306597f * sigmoidf_(w04[e] + cw[e])); a4[e] = sigmoidf_(a04[e] + ca[e]); }
                        const f32x4 r4 = (f32x4){bf_lo(rr[cb].x), bf_hi(rr[cb].x), bf_lo(rr[cb].y), bf_hi(rr[cb].y)}, k4 = (f32x4){bf_lo(kr[cb].x), bf_hi(kr[cb].x), bf_lo(kr[cb].y), bf_hi(kr[cb].y)};
                        const f32x4 v4 = (f32x4){bf_lo(vr[cb].x), bf_hi(vr[cb].x), bf_lo(vr[cb].y), bf_hi(vr[cb].y)};
                        const f32x4 kq = k4 * kk4; ssq += (kq[0] * kq[0] + kq[1] * kq[1]) + (kq[2] * kq[2] + kq[3] * kq[3]);
                        const f32x4 kn = k4 * (1.0f + (a4 - 1.0f) * ka4);
                        bo += (r4[0] * kn[0] * rk4[0] + r4[1] * kn[1] * rk4[1]) + (r4[2] * kn[2] * rk4[2] + r4[3] * kn[3] * rk4[3]);
                        const int o = tl * 64 + c0;
                        *(LAS f32x4*)(buf + o) = dec; *(LAS f32x4*)(buf + 3 * 2048 + o) = kn; *(LAS f32x4*)(buf + 4 * 2048 + o) = r4; *(LAS f32x4*)(buf + 5 * 2048 + o) = v4;
                        *(LAS f32x4*)(buf + 1 * 2048 + o) = kq; *(LAS f32x4*)(buf + 2 * 2048 + o) = kq * a4;
                        if ((cb >> 1) == half) { u32x2 w; w.x = cvt_pk_bf16(cgv[0], cgv[1]); w.y = cvt_pk_bf16(cgv[2], cgv[3]); __builtin_nontemporal_store(w, (u32x2*)(Gt + tok * C + h * 64 + c0)); } }
                    ssq += __shfl_xor(ssq, 16); ssq += __shfl_xor(ssq, 32); bo += __shfl_xor(bo, 16); bo += __shfl_xor(bo, 32);
                    const float inv = 1.0f / fmaxf(sqrtf(ssq), 1e-12f);
#pragma unroll
                    for (int cb = 0; cb < 4; ++cb) { const int o = tl * 64 + cb * 16 + fq * 4; const f32x4 kq = *(const LAS f32x4*)(buf + 1 * 2048 + o) * inv, bq = *(const LAS f32x4*)(buf + 2 * 2048 + o) * inv; *(LAS f32x4*)(buf + 1 * 2048 + o) = kq; *(LAS f32x4*)(buf + 2 * 2048 + o) = bq; }
                    if (half == 0 && fq == 0) bonus[tok * 16 + h] = bo;
                    if (cn + 1 < SEQ / 32) SC_PLOAD(cn + 1); }
            }
        } else {
            for (int c = -1; c < SEQ / 32 + 1; ++c) {
                if (c >= 0) LBAR();
                const int co = c - 1;
                if (co >= 0) { const LAS float* yi = sY + (co & 1) * 1024; const int ow = wv - 6, tl = ow * 16 + (lane >> 2), r8 = (lane & 3) * 8; const size_t tok = (size_t)(tok0 + co * 32 + tl);
                    const f32x4 y0 = *(const LAS f32x4*)(yi + tl * 32 + r8), y1 = *(const LAS f32x4*)(yi + tl * 32 + r8 + 4);
                    u32x4 w; w.x = cvt_pk_bf16(y0[0], y0[1]); w.y = cvt_pk_bf16(y0[2], y0[3]); w.z = cvt_pk_bf16(y1[0], y1[1]); w.w = cvt_pk_bf16(y1[2], y1[3]);
                    __builtin_nontemporal_store(w, (u32x4*)(Y + tok * C + h * 64 + half * 32 + r8));
                    float s1 = ((y0[0] + y0[1]) + (y0[2] + y0[3])) + ((y1[0] + y1[1]) + (y1[2] + y1[3]));
                    float s2 = ((y0[0] * y0[0] + y0[1] * y0[1]) + (y0[2] * y0[2] + y0[3] * y0[3])) + ((y1[0] * y1[0] + y1[1] * y1[1]) + (y1[2] * y1[2] + y1[3] * y1[3]));
                    s1 += dppf<0xB1>(s1); s1 += dppf<0x4E>(s1); s2 += dppf<0xB1>(s2); s2 += dppf<0x4E>(s2);
                    if ((lane & 3) == 0) gnst[(tok * 16 + h) * 2 + half] = (f32x2){s1, s2}; }
#pragma unroll 1
                for (int q2 = 0; q2 < 2; ++q2) if (wtile < LATE_TILES) { conv_tile8(p, ws, wtile, lane); wtile += cx.G * 2; }
            }
        }
    }
#undef SC_PLOAD
    if (wv >= 6) { while (wtile < LATE_TILES) { conv_tile8(p, ws, wtile, lane); wtile += cx.G * 2; } }
    LBAR();
}
__device__ __forceinline__ void phase_post(const Ctx& cx, PP p, unsigned char* ws) {
    const bf16_t* RK = (const bf16_t*)(ws + OFF_BIG); bf16_t* Y = (bf16_t*)(ws + OFF_BIG + BIG_Y); const bf16_t* Gt = (const bf16_t*)p->out;
    const float* bonus = (const float*)(ws + OFF_BONUS); const f32x4* gnst = (const f32x4*)(ws + OFF_GNST);
    const float* lnw = p->in[27]; const float* lnb = p->in[28];
    for (int i = cx.bid * 512 + cx.tid; i < T * 128; i += cx.G * 512) {
        const int t = i >> 7, c8 = (i & 127) * 8, h = c8 >> 6;
        const f32x4 stt = gnst[(size_t)t * 16 + h]; const float mean = (stt[0] + stt[2]) * (1.0f / 64.0f); const float var = fmaxf((stt[1] + stt[3]) * (1.0f / 64.0f) - mean * mean, 0.f);
        const float rs = rsqrtf(var + 64e-5f); const float bo = bonus[(size_t)t * 16 + h];
        const u32x4 yv = *(const u32x4*)(Y + (size_t)t * C + c8), gv = *(const u32x4*)(Gt + (size_t)t * C + c8), vv = *(const u32x4*)(RK + (size_t)t * NRK + 2048 + c8);
        const f32x4 lw0 = *(const f32x4*)(lnw + c8), lw1 = *(const f32x4*)(lnw + c8 + 4), lb0 = *(const f32x4*)(lnb + c8), lb1 = *(const f32x4*)(lnb + c8 + 4);
        float o[8];
#pragma unroll
        for (int e = 0; e < 4; ++e) { const unsigned yw = yv[e], gw = gv[e], vw = vv[e];
            const float l0 = e < 2 ? lw0[2 * e] : lw1[2 * e - 4], l1 = e < 2 ? lw0[2 * e + 1] : lw1[2 * e - 3], c0 = e < 2 ? lb0[2 * e] : lb1[2 * e - 4], c1 = e < 2 ? lb0[2 * e + 1] : lb1[2 * e - 3];
            o[2 * e] = ((bf_lo(yw) - mean) * rs * l0 + c0 + bo * bf_lo(vw)) * bf_lo(gw);
            o[2 * e + 1] = ((bf_hi(yw) - mean) * rs * l1 + c1 + bo * bf_hi(vw)) * bf_hi(gw); }
        u32x4 w; w.x = cvt_pk_bf16(o[0], o[1]); w.y = cvt_pk_bf16(o[2], o[3]); w.z = cvt_pk_bf16(o[4], o[5]); w.w = cvt_pk_bf16(o[6], o[7]);
        __builtin_nontemporal_store(w, (u32x4*)(Y + (size_t)t * C + c8));
    }
}
__device__ __forceinline__ void phase_spatial(const Ctx& cx, PP p, unsigned char* ws) {
    bf16_t* U = (bf16_t*)(ws + OFF_BIG); const bf16_t* V = (const bf16_t*)(ws + OFF_BIG + BIG_V); const bf16_t* WS16 = (const bf16_t*)(ws + OFF_WS16);
    const float* ssqv = (const float*)(ws + OFF_SSQV); const float* vnorm = p->in[31]; const float* bs = p->in[33];
    LAS unsigned char* sAw = cx.lds;
    LAS unsigned char* sVt = cx.lds + 128 * 272;
    LAS float* sRs = (LAS float*)(cx.lds + 128 * 272 + 128 * 260);
    const int tid = cx.tid, lane = cx.lane, wv = cx.wv, fr = lane & 15, fq = lane >> 4;
    int gl = -1;
    for (int unit = cx.bid; unit < 4096; unit += cx.G) {
        const int g = unit & 15, bc = unit >> 4; const int tok0 = bc * 128;
        LBAR();
        if (tid < 128) sRs[tid] = rsqrtf((ssq16(ssqv + (size_t)(tok0 + tid) * 32) + ssq16(ssqv + (size_t)(tok0 + tid) * 32 + 16)) * (1.0f / 2048.0f) + RMS_EPS);
        if (g != gl) { gl = g;
#pragma unroll
            for (int it = 0; it < 4; ++it) { const int idx = tid + it * 512, t = idx >> 4, sg = idx & 15; const u32x4 w = *(const u32x4*)(WS16 + (size_t)g * 16384 + t * 128 + sg * 8); *(LAS u32x4*)(sAw + t * 272 + sg * 16) = w; } }
        u32x4 vw[4];
#pragma unroll
        for (int it = 0; it < 4; ++it) { const int idx = tid + it * 512, s = idx >> 4, dg = idx & 15; vw[it] = *(const u32x4*)(V + (size_t)(tok0 + s) * 2048 + g * 128 + dg * 8); }
        LBAR();
#pragma unroll
        for (int it = 0; it < 4; ++it) { const int idx = tid + it * 512, s = idx >> 4, dg = idx & 15;
            const u32x4 w = vw[it]; const float rs = sRs[s];
            LAS unsigned* d = (LAS unsigned*)(sVt + s * 260 + dg * 16);
            d[0] = cvt_pk_bf16(bf_lo(w.x) * rs, bf_hi(w.x) * rs); d[1] = cvt_pk_bf16(bf_lo(w.y) * rs, bf_hi(w.y) * rs); d[2] = cvt_pk_bf16(bf_lo(w.z) * rs, bf_hi(w.z) * rs); d[3] = cvt_pk_bf16(bf_lo(w.w) * rs, bf_hi(w.w) * rs); }
        LBAR();
        bf16x8 bf[4];
#pragma unroll
        for (int ks = 0; ks < 4; ++ks)
#pragma unroll
            for (int e = 0; e < 8; ++e) bf[ks][e] = (short)*(const LAS unsigned short*)(sVt + (ks * 32 + fq * 8 + e) * 260 + (wv * 16 + fr) * 2);
        const int d4 = g * 128 + wv * 16 + fq * 4; const f32x4 vn4 = *(const f32x4*)(vnorm + d4);
        u32x2 uwv[8]; float bsa[8];
#pragma unroll
        for (int m = 0; m < 8; ++m) { const int t = m * 16 + fr; uwv[m] = *(const u32x2*)(U + (size_t)(tok0 + t) * 2048 + d4); bsa[m] = bs[g * 128 + t]; }
#pragma unroll
        for (int m = 0; m < 8; ++m) { f32x4 acc = (f32x4){0.f, 0.f, 0.f, 0.f};
#pragma unroll
            for (int ks = 0; ks < 4; ++ks) if (ks <= m / 2) { const bf16x8 af = *(const LAS bf16x8*)(sAw + (m * 16 + fr) * 272 + (ks * 32 + fq * 8) * 2); acc = __builtin_amdgcn_mfma_f32_16x16x32_bf16(bf[ks], af, acc, 0, 0, 0); }
            const int t = m * 16 + fr; const float bsv = bsa[m]; bf16_t* up = U + (size_t)(tok0 + t) * 2048 + d4; const u32x2 uw = uwv[m];
            const f32x4 sv = acc * vn4 + bsv; u32x2 w; w.x = cvt_pk_bf16(bf_lo(uw.x) * sv[0], bf_hi(uw.x) * sv[1]); w.y = cvt_pk_bf16(bf_lo(uw.y) * sv[2], bf_hi(uw.y) * sv[3]); __builtin_nontemporal_store(w, (u32x2*)up); }
    }
    LBAR();
}
__device__ __forceinline__ void phase_xattn(const Ctx& cx, PP p, unsigned char* ws) {
    const bf16_t* Q = (const bf16_t*)(ws + OFF_BIG); bf16_t* O = (bf16_t*)(ws + OFF_BIG + BIG_O); bf16_t* P = (bf16_t*)(ws + OFF_BIG + BIG_P) + (size_t)cx.bid * 65536;
    const bf16_t* MK = (const bf16_t*)(ws + OFF_MK); const bf16_t* VT = (const bf16_t*)(ws + OFF_VT);
    for (int unit = cx.bid; unit < 512; unit += cx.G) {
        const int pm = unit >> 2, h = unit & 3, b = pm >> 4; int kk = 256; asm volatile("" : "+s"(kk));
        { pg8::Gemm g{Q + (size_t)pm * 256 * C + h * 256, MK + (size_t)b * 256 * C + h * 256, 256, 256, kk, C, C, 0, nullptr, nullptr}; pg8::SingleUnit S; pg8::EpiSoftmax E{P};
            pg8::gemm_phase<pg8::EpiSoftmax, pg8::SingleUnit>(cx.lds, g, S, E); }
        __syncthreads();
        { pg8::Gemm g{P, VT + (size_t)h * 256 * 2048 + b * 256, 256, 256, kk, 256, 2048, 0, nullptr, nullptr}; pg8::SingleUnit S; pg8::EpiB<0> E{O, C, pm * 256, h * 256, nullptr, nullptr, nullptr};
            pg8::gemm_phase<pg8::EpiB<0>, pg8::SingleUnit>(cx.lds, g, S, E); }
        __syncthreads();
    }
}

#define XB_TMO      128
#define XB_XCNT(j)  (256  + 64 * (j))
#define XB_XSUB(j)  (1280 + 64 * (j))
#define XB_XGEN(j)  (2304 + 64 * (j))
#define XB_TOP      3328
#define XB_TOPGEN   3392
#define XCD_BAR_WORDS 3456
#define XB_SPIN_CAP (1u << 18)
__device__ __forceinline__ unsigned xb_ld(unsigned* p)              { return __hip_atomic_load(p, __ATOMIC_RELAXED, __HIP_MEMORY_SCOPE_AGENT); }
__device__ __forceinline__ unsigned xb_add(unsigned* p, unsigned v) { return __hip_atomic_fetch_add(p, v, __ATOMIC_RELAXED, __HIP_MEMORY_SCOPE_AGENT); }
__device__ __forceinline__ unsigned xb_xcc_id() { return (unsigned)__builtin_amdgcn_s_getreg((3 << 11) | 20) & 0xFu; }
#define XB_SPIN(cond, bar) do { unsigned _sp = 0; while (cond) { __builtin_amdgcn_s_sleep(1); \
    if ((++_sp & 255u) == 0u) { if (xb_ld(&(bar)[XB_TMO])) break; if (_sp > XB_SPIN_CAP) { atomicAdd(&(bar)[XB_TMO], 1u); break; } } } } while (0)
struct XcdBarrier { unsigned* bar; unsigned x; volatile LAS unsigned* st; };
__device__ __forceinline__ XcdBarrier xcd_barrier_post(unsigned* bar, volatile LAS unsigned* st) {
    XcdBarrier b; b.bar = bar; b.x = xb_xcc_id(); b.st = st;
    if (threadIdx.x == 0) (void)xb_add(&bar[XB_XCNT(b.x)], 1u);
    return b;
}
__device__ __forceinline__ void xcd_barrier_complete(unsigned* bar, unsigned x, unsigned& nloc, unsigned& nx) {
    const unsigned G = gridDim.x * gridDim.y * gridDim.z;
    unsigned sum, cnt, mine, sp = 0u;
    for (;;) {
        sum = 0u; cnt = 0u; mine = 0u;
#pragma unroll
        for (unsigned j = 0; j < 16; ++j) { const unsigned c = xb_ld(&bar[XB_XCNT(j)]); sum += c; cnt += (c > 0u) ? 1u : 0u; mine = (j == x) ? c : mine; }
        if (sum == G) break;
        __builtin_amdgcn_s_sleep(1);
        if ((++sp & 255u) == 0u) { if (xb_ld(&bar[XB_TMO])) break; if (sp > XB_SPIN_CAP) { atomicAdd(&bar[XB_TMO], 1u); break; } }
    }
    nloc = mine > 0u ? mine : 1u; nx = cnt > 0u ? cnt : 1u;
}
__device__ __forceinline__ void xcd_barrier(const XcdBarrier& b) {
    asm volatile("s_waitcnt vmcnt(0)" ::: "memory");
    __syncthreads();
    if (threadIdx.x == 0) {
        unsigned* bar = b.bar;
        __builtin_amdgcn_s_waitcnt(0);
        unsigned nloc = b.st[0], nx = b.st[1];
        if (nloc == 0u) { xcd_barrier_complete(bar, b.x, nloc, nx); b.st[0] = nloc; b.st[1] = nx; }
        const unsigned old = xb_add(&bar[XB_XSUB(b.x)], 1u);
        const unsigned gen = old / nloc;
        if (old + 1u == (gen + 1u) * nloc) {
            __builtin_amdgcn_fence(__ATOMIC_RELEASE, "agent");
            asm volatile("s_waitcnt vmcnt(0)" ::: "memory");
            const unsigned og = xb_add(&bar[XB_TOP], 1u);
            const unsigned tg = og / nx;
            if (og + 1u == (tg + 1u) * nx) xb_add(&bar[XB_TOPGEN], 1u);
            else XB_SPIN(xb_ld(&bar[XB_TOPGEN]) == tg, bar);
            __builtin_amdgcn_fence(__ATOMIC_ACQUIRE, "agent");
            xb_add(&bar[XB_XGEN(b.x)], 1u);
            asm volatile("s_waitcnt vmcnt(0)" ::: "memory");
        } else {
            XB_SPIN(xb_ld(&bar[XB_XGEN(b.x)]) == gen, bar);
            __builtin_amdgcn_fence(__ATOMIC_ACQUIRE, "agent");
            asm volatile("s_waitcnt vmcnt(0)" ::: "memory");
        }
    }
    __syncthreads();
}

enum { OP_PREP, OP_MEMKV_FFNIN, OP_FFN_IN, OP_FFN_OUT, OP_HN, OP_RWKV_PROJ, OP_SCAN, OP_POST, OP_RWKV_OUT, OP_XQ, OP_XATT, OP_XO, OP_G1, OP_SPATIAL, OP_G3, OP_FINAL, OP_LORA, OP_PREMIX };
constexpr int NPHASE = 25;

__global__ void __launch_bounds__(512, 2) fwd_kernel(Params p_) {
    extern __shared__ __attribute__((aligned(16))) unsigned char smem[];
    cg::grid_group grid = cg::this_grid();
    { volatile LAS unsigned* stw = (volatile LAS unsigned*)((LAS unsigned char*)smem + LDS_BAR); if (threadIdx.x < 4) stw[threadIdx.x] = 0u; }
    __syncthreads();
    XcdBarrier xbar = xcd_barrier_post((unsigned*)(p_.ws + OFF_BAR), (volatile LAS unsigned*)((LAS unsigned char*)smem + LDS_BAR));
    int rep = 0;
    for (int ph = p_.ph_lo; ph < p_.ph_hi; ++ph) {
        PP p = (PP)__builtin_amdgcn_kernarg_segment_ptr(); asm volatile("" : "+s"(p));
        int tid_ = threadIdx.x; asm volatile("" : "+v"(tid_));
        Ctx cx; cx.tid = tid_; cx.lane = cx.tid & 63; cx.wv = __builtin_amdgcn_readfirstlane(cx.tid >> 6); { int g_ = gridDim.x, b_ = blockIdx.x; asm volatile("" : "+s"(g_), "+s"(b_)); cx.G = g_; cx.bid = b_; }
        cx.lds = (LAS unsigned char*)smem;
        unsigned char* ws = p->ws;
        float* ssqb = (float*)(ws + OFF_SSQ);
        bf16_t* XB = (bf16_t*)(ws + OFF_XB); bf16_t* BIG = (bf16_t*)(ws + OFF_BIG);
        int op, l = 0, f = 0;
        switch (ph) {
            case 0: op = OP_PREP; break;
            case 1: op = OP_MEMKV_FFNIN; break;
            case 2: op = OP_FFN_OUT; break;
            case 3: op = OP_PREMIX; break;
            case 4: op = OP_LORA; break;
            case 5: op = OP_RWKV_PROJ; break;
            case 6: op = OP_SCAN; break;
            case 7: op = OP_POST; break;
            case 8: op = OP_RWKV_OUT; break;
            case 9: op = OP_XQ; break;
            case 10: op = OP_XATT; break;
            case 11: op = OP_XO; break;
            case 12: op = OP_FFN_IN; f = 1; break;
            case 13: op = OP_FFN_OUT; f = 1; break;
            case 14: op = OP_FFN_IN; l = 1; break;
            case 15: op = OP_FFN_OUT; l = 1; break;
            case 16: op = OP_G1; l = 1; break;
            case 17: op = OP_SPATIAL; l = 1; break;
            case 18: op = OP_G3; l = 1; break;
            case 19: op = OP_XQ; l = 1; break;
            case 20: op = OP_XATT; l = 1; break;
            case 21: op = OP_XO; l = 1; break;
            case 22: op = OP_FFN_IN; l = 1; f = 1; break;
            case 23: op = OP_FFN_OUT; l = 1; f = 1; break;
            default: op = OP_FINAL; break;
        }
        if (EN(OP_PREP) && op == OP_PREP) phase_prep(cx, p, ws);
        if (EN(OP_MEMKV_FFNIN) && op == OP_MEMKV_FFNIN) {
            { pg8::Gemm g{(const bf16_t*)(ws + OFF_MEMN), (const bf16_t*)(ws + OFF_WMK), 2048, 1024, 1024, 1024, 1024, 0, nullptr, nullptr}; pg8::StaticOrder S; S.init(2048, 1024, cx.G, cx.bid);
                pg8::EpiB<0> E{(bf16_t*)(ws + OFF_MK), 1024, 0, 0, nullptr, nullptr, nullptr}; pg8::gemm_phase<pg8::EpiB<0>, pg8::StaticOrder>(cx.lds, g, S, E); }
            { pg8::Gemm g{(const bf16_t*)(ws + OFF_WMV), (const bf16_t*)(ws + OFF_MEMN), 1024, 2048, 1024, 1024, 1024, 0, nullptr, nullptr}; pg8::StaticOrder S; S.init(1024, 2048, cx.G, (cx.bid + cx.G / 2) % cx.G);
                pg8::EpiB<0> E{(bf16_t*)(ws + OFF_VT), 2048, 0, 0, nullptr, nullptr, nullptr}; pg8::gemm_phase<pg8::EpiB<0>, pg8::StaticOrder>(cx.lds, g, S, E); }
        }
        if (EN(OP_FFN_IN) && (op == OP_MEMKV_FFNIN || op == OP_FFN_IN)) {
            pg8::Gemm g{XB, (const bf16_t*)(ws + OFF_WIN + (size_t)(l * 2 + f) * SZ_WIN), T, 5632, 1024, 1024, 1024, 0, nullptr, nullptr}; pg8::StaticOrder S; S.init(T, 5632, cx.G, cx.bid);
            pg8::EpiSwiGLU E{BIG, ssqb + (size_t)(l * 4 + (f ? 3 : 0)) * T * 4}; pg8::gemm_phase<pg8::EpiSwiGLU, pg8::StaticOrder>(cx.lds, g, S, E);
        }
        if (EN(OP_FFN_OUT) && (op == OP_FFN_OUT || op == OP_RWKV_OUT || op == OP_XO || op == OP_G3)) {
            const bf16_t* A; const bf16_t* Bt; int K; float alpha = 1.0f; int so;
            if (op == OP_FFN_OUT) { A = BIG; Bt = (const bf16_t*)(ws + OFF_WOUT + (size_t)(l * 2 + f) * SZ_WOUT); K = FF; alpha = 0.5f; so = l * 4 + (f ? 4 : 1); }
            else if (op == OP_RWKV_OUT) { A = (const bf16_t*)(ws + OFF_BIG + BIG_Y); Bt = (const bf16_t*)(ws + OFF_RWO); K = 1024; so = 2; }
            else if (op == OP_XO) { A = (const bf16_t*)(ws + OFF_BIG + BIG_O); Bt = (const bf16_t*)(ws + OFF_WO + (size_t)l * SZ_SQ); K = 1024; so = l * 4 + 3; }
            else { A = BIG; Bt = (const bf16_t*)(ws + OFF_GWO); K = 2048; so = 6; }
            pg8::Gemm g{A, Bt, T, 1024, K, K, K, 0, nullptr, nullptr}; pg8::StaticOrder S; S.init(T, 1024, cx.G, cx.bid);
            pg8::EpiResid E{XB, ssqb + (size_t)so * T * 4, alpha, cx.lds}; pg8::gemm_phase<pg8::EpiResid, pg8::StaticOrder>(cx.lds, g, S, E);
        }
        if (EN(OP_HN) && op == OP_HN) phase_hn(cx, p, ws);
        if (EN(OP_LORA) && op == OP_LORA) {
            pg8::Gemm g{(const bf16_t*)(ws + OFF_BIG), (const bf16_t*)(ws + OFF_WLO), T, NLO, 2048, 1024, 2048, (size_t)1024 * 2, nullptr, nullptr}; pg8::StaticOrder S; S.init(T, NLO, cx.G, cx.bid);
            pg8::EpiB<2> E{(bf16_t*)(ws + OFF_BIG + BIG_L), NLO, 0, 0, nullptr, nullptr, nullptr}; pg8::gemm_phase<pg8::EpiB<2>, pg8::StaticOrder>(cx.lds, g, S, E);
        }
        if (EN(OP_PREMIX) && op == OP_PREMIX) phase_premix(cx, p, ws);
        if (EN(OP_RWKV_PROJ) && op == OP_RWKV_PROJ) {
            const bf16_t* xr = (const bf16_t*)p->out;
            pg8::Gemm g{xr, (const bf16_t*)(ws + OFF_WRK), T, NRK, 1024, 1024, 1024, 0, xr + (size_t)T * C, (const bf16_t*)(ws + OFF_BIG + BIG_Y)}; pg8::StaticOrder S; S.init(T, NRK, cx.G, cx.bid);
            pg8::EpiB<0> E{BIG, NRK, 0, 0, nullptr, nullptr, nullptr}; pg8::gemm_phase<pg8::EpiB<0>, pg8::StaticOrder>(cx.lds, g, S, E);
        }
        if (EN(OP_SCAN) && op == OP_SCAN) phase_scan(cx, p, ws);
        if (EN(OP_POST) && op == OP_POST) phase_post(cx, p, ws);
        if (EN(OP_XQ) && op == OP_XQ) {
            pg8::Gemm g{XB, (const bf16_t*)(ws + OFF_WQ + (size_t)l * SZ_SQ), T, 1024, 1024, 1024, 1024, 0, nullptr, nullptr}; pg8::StaticOrder S; S.init(T, 1024, cx.G, cx.bid);
            pg8::EpiB<1> E{BIG, 1024, 0, 0, ssqb + (size_t)(l * 4 + 2) * T * 4, nullptr, nullptr}; pg8::gemm_phase<pg8::EpiB<1>, pg8::StaticOrder>(cx.lds, g, S, E);
        }
        if (EN(OP_XATT) && op == OP_XATT) phase_xattn(cx, p, ws);
        if (EN(OP_G1) && op == OP_G1) {
            pg8::Gemm g{XB, (const bf16_t*)(ws + OFF_GUV), T, 4096, 1024, 1024, 1024, 0, nullptr, nullptr}; pg8::StaticOrder S; S.init(T, 4096, cx.G, cx.bid);
            pg8::EpiB<3> E{BIG, 2048, 0, 0, ssqb + (size_t)5 * T * 4, (float*)(ws + OFF_SSQV), (bf16_t*)(ws + OFF_BIG + BIG_V)}; pg8::gemm_phase<pg8::EpiB<3>, pg8::StaticOrder>(cx.lds, g, S, E);
        }
        if (EN(OP_SPATIAL) && op == OP_SPATIAL) phase_spatial(cx, p, ws);
        if (EN(OP_FINAL) && op == OP_FINAL) phase_final(cx, p, ws);
        if (ph + 1 < p_.ph_hi) { if (p_.ph_hi > 1000) grid.sync(); else { XcdBarrier xb2 = xbar; asm volatile("" : "+s"(xb2.bar)); xcd_barrier(xb2); } }
        if (ph == REP_PH && rep < REP_N) { ++rep; --ph; }
    }
}

extern "C" void kernel_launch(void* const* d_in, const int* in_sizes, int n_in, void* d_out, int out_size, void* d_ws, size_t ws_size, hipStream_t stream) {
    static int grid = 0;
    if (grid == 0) {
        if (n_in != 36 || ws_size < WS_END) { fprintf(stderr, "kernel_launch: expected 36 inputs and >= %zu bytes of workspace (got %d, %zu)\n", (size_t)WS_END, n_in, ws_size); grid = -1; return; }
        int dev = 0, cus = 0, per_cu = 0;
        hipGetDevice(&dev); hipDeviceGetAttribute(&cus, hipDeviceAttributeMultiprocessorCount, dev);
        if (hipFuncSetAttribute((const void*)fwd_kernel, hipFuncAttributeMaxDynamicSharedMemorySize, LDS_BYTES) != hipSuccess) { fprintf(stderr, "kernel_launch: hipFuncSetAttribute failed\n"); grid = -1; return; }
        if (hipOccupancyMaxActiveBlocksPerMultiprocessor(&per_cu, (const void*)fwd_kernel, 512, LDS_BYTES) != hipSuccess || per_cu < 1) { fprintf(stderr, "kernel_launch: occupancy query says %d\n", per_cu); per_cu = 1; }
        (void)hipGetLastError();
        grid = cus * 1;
    }
    if (grid < 0) return;
    Params p{};
    for (int i = 0; i < 36; ++i) p.in[i] = (const float*)d_in[i];
    p.out = (float*)d_out; p.ws = (unsigned char*)d_ws;
#if MEGA
    (void)hipMemsetAsync((unsigned char*)d_ws + OFF_BAR, 0, 16384, stream);
    p.ph_lo = 0; p.ph_hi = NPHASE;
    void* args[] = {&p};
    hipError_t e = hipLaunchCooperativeKernel((const void*)fwd_kernel, dim3(grid), dim3(512), args, LDS_BYTES, stream);
    if (e != hipSuccess) fprintf(stderr, "cooperative launch failed: %s (grid %d)\n", hipGetErrorString(e), grid);
#else
    for (int ph = 0; ph < NPHASE; ++ph) { p.ph_lo = ph; p.ph_hi = ph + 1; hipLaunchKernelGGL(fwd_kernel, dim3(grid), dim3(512), LDS_BYTES, stream, p); }
#endif
}
```
